# Optimizing an MI355X kernel written in HIP

```python
import math
import jax, jax.numpy as jnp
from jax import lax
import numpy as np

D_MODEL = 1024
BATCH = 16
SEQ = 2048
DEPTH = 4

H_A = 8
HD_A = 64
DILATED_PAIRS = ((128, 1), (512, 4), (2048, 16))
H_B = 8
HD_B = 64
H_C = 8
Q_LORA = 256
KV_LORA = 128
NOPE_C = 64
ROPE_C = 32
V_C = 64
ROPE_THETA = 10000.0
N_BRANCHES = 3
BRANCH_WIDTH = 512
N_BUCKETS = 32
MAX_DISTANCE = 2048
Q_BLOCK = 128
N_GROUPS = 4
EXPERTS_PER_GROUP = 4
N_EXPERTS = 16
TOP_K = 2
D_FF_EXPERT = 256
EPS = 1e-6
IN_SPLIT_SIZES = (3 * H_A * HD_A, 3 * H_B * HD_B, H_B, Q_LORA, KV_LORA, ROPE_C, N_BRANCHES * D_MODEL)
D_IN = 3 * H_A * HD_A + 3 * H_B * HD_B + H_B + Q_LORA + KV_LORA + ROPE_C + N_BRANCHES * D_MODEL

kernel_name = 'hybrid_dilated_fox_mla_hiermoe'


def rms_norm(x, g):
    xf = x.astype(jnp.float32)
    y = xf * lax.rsqrt(jnp.mean(xf * xf, axis=-1, keepdims=True) + EPS)
    return (y * g.astype(jnp.float32)).astype(x.dtype)


def t5_bucket(dist):
    max_exact = N_BUCKETS // 2
    log_ratio = np.log(np.maximum(dist, max_exact) / max_exact) / np.log(MAX_DISTANCE / max_exact)
    large = np.minimum(max_exact + (log_ratio * (N_BUCKETS - max_exact)).astype(np.int32), N_BUCKETS - 1)
    return np.where(dist < max_exact, dist, large).astype(np.int32)


def rope_tables(positions, dim):
    half = dim // 2
    inv_freq = ROPE_THETA ** (-jnp.arange(half, dtype=jnp.float32) / half)
    ang = positions.astype(jnp.float32)[..., None] * inv_freq
    return jnp.cos(ang)[:, :, None, :], jnp.sin(ang)[:, :, None, :]


def apply_rope(x, cos, sin):
    half = x.shape[-1] // 2
    x1, x2 = x[..., :half], x[..., half:]
    c, s = cos.astype(x.dtype), sin.astype(x.dtype)
    return jnp.concatenate([x1 * c - x2 * s, x1 * s + x2 * c], axis=-1)


def dilated_branch(q, k, v, rel_bias, window_sub, dil):
    b, s_len, h, hd = q.shape
    n_sub = s_len // dil
    nb = -(-n_sub // Q_BLOCK)
    pad_end = nb * Q_BLOCK - n_sub

    def to_sub(t):
        return t.reshape(b, n_sub, dil, h, hd).transpose(0, 2, 3, 1, 4)

    qs = jnp.pad(to_sub(q), ((0, 0), (0, 0), (0, 0), (0, pad_end), (0, 0))).reshape(b, dil, h, nb, Q_BLOCK, hd)

    def kv_blocks(t):
        t = jnp.pad(to_sub(t), ((0, 0), (0, 0), (0, 0), (Q_BLOCK, pad_end), (0, 0)))
        t = t.reshape(b, dil, h, nb + 1, Q_BLOCK, hd)
        return jnp.concatenate([t[:, :, :, :-1], t[:, :, :, 1:]], axis=4)

    kb, vb = kv_blocks(k), kv_blocks(v)
    qi = np.arange(Q_BLOCK)[:, None]
    km = np.arange(2 * Q_BLOCK)[None, :]
    dist = qi + Q_BLOCK - km
    band = (dist >= 0) & (dist <= window_sub)
    valid = band[None] & ((np.arange(nb)[:, None, None] > 0) | (km[None] >= Q_BLOCK))
    bias = rel_bias[t5_bucket(np.maximum(dist, 0) * dil)].astype(jnp.float32).transpose(2, 0, 1)
    scores = jnp.einsum('bchnqd,bchnkd->bchnqk', qs, kb, preferred_element_type=jnp.float32) / math.sqrt(hd)
    scores = jnp.where(valid, scores + bias[:, None], -jnp.inf)
    m = jnp.max(scores, axis=-1, keepdims=True)
    p = jnp.exp(scores - m)
    den = jnp.sum(p, axis=-1, keepdims=True)
    o = jnp.einsum('bchnqk,bchnkd->bchnqd', p.astype(v.dtype), vb, preferred_element_type=jnp.float32) / den
    lse = (m + jnp.log(den))[..., 0]
    o = o.reshape(b, dil, h, nb * Q_BLOCK, hd)[:, :, :, :n_sub].transpose(0, 3, 1, 2, 4).reshape(b, s_len, h, hd)
    lse = lse.reshape(b, dil, h, nb * Q_BLOCK)[:, :, :, :n_sub].transpose(0, 3, 1, 2).reshape(b, s_len, h)
    return o, lse


def dilated_mixture(q, k, v, rel_bias):
    outs, lses = [], []
    for window, dil in DILATED_PAIRS:
        o, lse = dilated_branch(q, k, v, rel_bias, window // dil, dil)
        outs.append(o)
        lses.append(lse)
    w = jax.nn.softmax(jnp.stack(lses, axis=0), axis=0)
    o = jnp.sum(jnp.stack(outs, axis=0) * w[..., None], axis=0)
    return o.astype(q.dtype)


def causal_block_attention(q, k, v, scale, log_decay_cum=None):
    b, h, s_len, _ = q.shape
    dv = v.shape[-1]
    nb = s_len // Q_BLOCK
    kpos = jnp.arange(s_len)

    def one_block(j):
        start = j * Q_BLOCK
        qb = lax.dynamic_slice_in_dim(q, start, Q_BLOCK, axis=2)
        s = jnp.einsum('bhqd,bhkd->bhqk', qb, k, preferred_element_type=jnp.float32) * scale
        if log_decay_cum is not None:
            cq = lax.dynamic_slice_in_dim(log_decay_cum, start, Q_BLOCK, axis=2)
            s = s + cq[..., :, None] - log_decay_cum[..., None, :]
        qpos = start + jnp.arange(Q_BLOCK)
        s = jnp.where(kpos[None, :] <= qpos[:, None], s, -jnp.inf)
        p = jax.nn.softmax(s, axis=-1)
        return jnp.einsum('bhqk,bhkd->bhqd', p.astype(v.dtype), v)

    out = lax.map(one_block, jnp.arange(nb))
    return jnp.moveaxis(out, 0, 2).reshape(b, h, s_len, dv)


def hierarchical_moe(xn, w_rg, b_rg, w_re, b_re, w_g, w_u, w_d):
    b, s_len, d = xn.shape
    t = xn.reshape(-1, d)
    g_logits = jnp.einsum('td,dg->tg', t, w_rg, preferred_element_type=jnp.float32) + b_rg.astype(jnp.float32)
    p_group = jax.nn.softmax(g_logits, axis=-1)
    pg_top, g_idx = lax.top_k(p_group, 1)
    e_logits = (jnp.einsum('td,de->te', t, w_re, preferred_element_type=jnp.float32)
                + b_re.astype(jnp.float32)).reshape(-1, N_GROUPS, EXPERTS_PER_GROUP)
    e_sel = jnp.einsum('tge,tg->te', e_logits, jax.nn.one_hot(g_idx[:, 0], N_GROUPS, dtype=jnp.float32))
    ev, e_idx = lax.top_k(e_sel, TOP_K)
    w_e = jax.nn.softmax(ev, axis=-1) * pg_top
    gid = g_idx * EXPERTS_PER_GROUP + e_idx
    gates = jnp.sum(jax.nn.one_hot(gid, N_EXPERTS, dtype=jnp.float32) * w_e[..., None], axis=1).astype(t.dtype)
    y = jnp.zeros_like(t)
    for e in range(N_EXPERTS):
        hid = jax.nn.silu(t @ w_g[e]) * (t @ w_u[e])
        y = y + gates[:, e:e + 1] * (hid @ w_d[e])
    return y.reshape(b, s_len, d)


def setup_inputs(seed: int = 0) -> dict:
    key = jax.random.key(seed)
    ks = jax.random.split(key, 26)
    f32 = jnp.float32
    L = DEPTH

    def dense(k, shape, fan_in):
        return jax.random.normal(k, shape, f32) * fan_in ** -0.5

    def gain(k, shape):
        return 1.0 + 0.05 * jax.random.normal(k, shape, f32)

    x = jax.random.normal(ks[0], (BATCH, SEQ, D_MODEL), f32)
    offset = jax.random.randint(ks[1], (BATCH, 1), 0, 4096, dtype=jnp.int32)
    positions = offset + jnp.arange(SEQ, dtype=jnp.int32)[None, :]
    return {
        'x': x,
        'positions': positions,
        'rel_bias': 0.1 * jax.random.normal(ks[2], (N_BUCKETS, H_A), f32),
        'norm_mix': gain(ks[3], (L, D_MODEL)),
        'w_in': dense(ks[4], (L, D_MODEL, D_IN), D_MODEL),
        'b_forget': 1.0 + 2.0 * jax.random.uniform(ks[5], (L, H_B), f32),
        'gq_a': gain(ks[6], (L, HD_A)),
        'gk_a': gain(ks[7], (L, HD_A)),
        'gq_b': gain(ks[8], (L, HD_B)),
        'gk_b': gain(ks[9], (L, HD_B)),
        'gq_c': gain(ks[10], (L, NOPE_C + ROPE_C)),
        'gk_c': gain(ks[11], (L, NOPE_C + ROPE_C)),
        'norm_cq': gain(ks[12], (L, Q_LORA)),
        'norm_ckv': gain(ks[13], (L, KV_LORA)),
        'w_uq': dense(ks[14], (L, Q_LORA, H_C * (NOPE_C + ROPE_C)), Q_LORA),
        'w_ukv': dense(ks[15], (L, KV_LORA, H_C * (NOPE_C + V_C)), KV_LORA),
        'w_branch': dense(ks[16], (L, N_BRANCHES, BRANCH_WIDTH, D_MODEL), BRANCH_WIDTH),
        'w_out': dense(ks[17], (L, D_MODEL, D_MODEL), D_MODEL),
        'norm_ffn': gain(ks[18], (L, D_MODEL)),
        'w_router_group': dense(ks[19], (L, D_MODEL, N_GROUPS), D_MODEL),
        'b_router_group': 0.01 * jax.random.normal(ks[20], (L, N_GROUPS), f32),
        'w_router_expert': dense(ks[21], (L, D_MODEL, N_EXPERTS), D_MODEL),
        'b_router_expert': 0.01 * jax.random.normal(ks[22], (L, N_EXPERTS), f32),
        'w_expert_gate': dense(ks[23], (L, N_EXPERTS, D_MODEL, D_FF_EXPERT), D_MODEL),
        'w_expert_up': dense(ks[24], (L, N_EXPERTS, D_MODEL, D_FF_EXPERT), D_MODEL),
        'w_expert_down': dense(ks[25], (L, N_EXPERTS, D_FF_EXPERT, D_MODEL), D_FF_EXPERT),
    }


def reference(x, positions, rel_bias, norm_mix, w_in, b_forget, gq_a, gk_a, gq_b, gk_b, gq_c, gk_c,
              norm_cq, norm_ckv, w_uq, w_ukv, w_branch, w_out, norm_ffn, w_router_group, b_router_group,
              w_router_expert, b_router_expert, w_expert_gate, w_expert_up, w_expert_down):
    b, s_len, d = x.shape
    cos, sin = rope_tables(positions, ROPE_C)
    split_points = [int(i) for i in np.cumsum(IN_SPLIT_SIZES)[:-1]]
    for l in range(DEPTH):
        xn = rms_norm(x, norm_mix[l])
        h = xn @ w_in[l]
        ha, hb, hf, hcq, hckv, hkr, hg = jnp.split(h, split_points, axis=-1)

        qa, ka, va = [t.reshape(b, s_len, H_A, HD_A) for t in jnp.split(ha, 3, axis=-1)]
        o_a = dilated_mixture(rms_norm(qa, gq_a[l]), rms_norm(ka, gk_a[l]), va, rel_bias)
        o_a = o_a.reshape(b, s_len, BRANCH_WIDTH)

        qb, kb, vb = [t.reshape(b, s_len, H_B, HD_B).transpose(0, 2, 1, 3) for t in jnp.split(hb, 3, axis=-1)]
        log_f = jax.nn.log_sigmoid(hf.astype(jnp.float32) + b_forget[l].astype(jnp.float32))
        cum = jnp.cumsum(log_f, axis=1).transpose(0, 2, 1)
        o_b = causal_block_attention(rms_norm(qb, gq_b[l]), rms_norm(kb, gk_b[l]), vb, 1.0 / math.sqrt(HD_B), cum)
        o_b = o_b.transpose(0, 2, 1, 3).reshape(b, s_len, BRANCH_WIDTH)

        qc = (rms_norm(hcq, norm_cq[l]) @ w_uq[l]).reshape(b, s_len, H_C, NOPE_C + ROPE_C)
        kvc = (rms_norm(hckv, norm_ckv[l]) @ w_ukv[l]).reshape(b, s_len, H_C, NOPE_C + V_C)
        q_nope = rms_norm(qc[..., :NOPE_C], gq_c[l][:NOPE_C])
        q_rope = apply_rope(rms_norm(qc[..., NOPE_C:], gq_c[l][NOPE_C:]), cos, sin)
        k_nope = rms_norm(kvc[..., :NOPE_C], gk_c[l][:NOPE_C])
        vc = kvc[..., NOPE_C:]
        k_rope = apply_rope(rms_norm(hkr, gk_c[l][NOPE_C:])[:, :, None, :], cos, sin)
        q_full = jnp.concatenate([q_nope, q_rope], axis=-1).transpose(0, 2, 1, 3)
        k_full = jnp.concatenate([k_nope, jnp.broadcast_to(k_rope, (b, s_len, H_C, ROPE_C))], axis=-1).transpose(0, 2, 1, 3)
        o_c = causal_block_attention(q_full, k_full, vc.transpose(0, 2, 1, 3), 1.0 / math.sqrt(NOPE_C + ROPE_C))
        o_c = o_c.transpose(0, 2, 1, 3).reshape(b, s_len, BRANCH_WIDTH)

        branches = jnp.stack([o_a, o_b, o_c], axis=2)
        proj = jnp.einsum('bsgc,gcd->bsgd', branches, w_branch[l])
        gates = jax.nn.sigmoid(hg.reshape(b, s_len, N_BRANCHES, d))
        x = x + jnp.sum(gates * proj, axis=2) @ w_out[l]

        x = x + hierarchical_moe(rms_norm(x, norm_ffn[l]), w_router_group[l], b_router_group[l],
                                 w_router_expert[l], b_router_expert[l], w_expert_gate[l],
                                 w_expert_up[l], w_expert_down[l])
    return x
```

```cpp
#include <hip/hip_runtime.h>
#include <cstdint>
#include <cstdio>
#include <cmath>

constexpr int D_MODEL = 1024, BATCH = 16, SEQ = 2048, DEPTH = 4, T_ALL = BATCH * SEQ;
constexpr int D_IN = 6568;
constexpr int OFF_A = 0, OFF_B = 1536, OFF_F = 3072, OFF_CQ = 3080, OFF_CKV = 3336, OFF_KR = 3464, OFF_G = 3496;

__constant__ unsigned char T5B[3][129] = {
{0,1,2,3,4,5,6,7,8,9,10,11,12,13,14,15,16,16,16,16,16,16,17,17,17,17,17,17,17,17,18,18,18,18,18,18,18,18,18,18,19,19,19,19,19,19,19,19,19,19,19,19,19,19,20,20,20,20,20,20,20,20,20,20,20,20,20,20,20,20,20,20,20,21,21,21,21,21,21,21,21,21,21,21,21,21,21,21,21,21,21,21,21,21,21,21,21,21,21,22,22,22,22,22,22,22,22,22,22,22,22,22,22,22,22,22,22,22,22,22,22,22,22,22,22,22,22,22,22},
{0,4,8,12,16,16,17,17,18,18,19,19,19,19,20,20,20,20,20,21,21,21,21,21,21,22,22,22,22,22,22,22,22,22,23,23,23,23,23,23,23,23,23,23,23,23,24,24,24,24,24,24,24,24,24,24,24,24,24,24,24,24,25,25,25,25,25,25,25,25,25,25,25,25,25,25,25,25,25,25,25,25,25,26,26,26,26,26,26,26,26,26,26,26,26,26,26,26,26,26,26,26,26,26,26,26,26,26,26,26,26,26,26,27,27,27,27,27,27,27,27,27,27,27,27,27,27,27,27},
{0,16,18,19,20,21,21,22,22,23,23,23,24,24,24,24,25,25,25,25,25,26,26,26,26,26,26,26,26,27,27,27,27,27,27,27,27,27,27,28,28,28,28,28,28,28,28,28,28,28,28,28,29,29,29,29,29,29,29,29,29,29,29,29,29,29,29,29,29,29,30,30,30,30,30,30,30,30,30,30,30,30,30,30,30,30,30,30,30,30,30,30,30,30,30,31,31,31,31,31,31,31,31,31,31,31,31,31,31,31,31,31,31,31,31,31,31,31,31,31,31,31,31,31,31,31,31,31,31}};

__device__ __forceinline__ float wave_sum(float v) {
#pragma unroll
    for (int o = 32; o > 0; o >>= 1) v += __shfl_xor(v, o);
    return v;
}

__global__ __launch_bounds__(256) void bl_rms(const float* in, int ld_in, int gs_in, const float* g, float* out, int ld_out, int gs_out, int nrows, int G, int nc) {
    const int w = blockIdx.x * 4 + (threadIdx.x >> 6), lane = threadIdx.x & 63;
    if (w >= nrows * G) return;
    const int r = w / G, gi = w % G;
    const float* p = in + (size_t)r * ld_in + gi * gs_in;
    float* q = out + (size_t)r * ld_out + gi * gs_out;
    float s = 0.f;
    for (int c = lane; c < nc; c += 64) { const float v = p[c]; s += v * v; }
    s = wave_sum(s);
    const float rs = rsqrtf(s / (float)nc + 1e-6f);
    for (int c = lane; c < nc; c += 64) q[c] = p[c] * rs * g[c];
}

__global__ __launch_bounds__(256) void bl_rope(const float* in, int ld_in, int gs_in, const float* g, const int* pos, float* out, int ld_out, int gs_out, int nrows, int G, int nrep) {
    const int w = blockIdx.x * 4 + (threadIdx.x >> 6), lane = threadIdx.x & 63;
    if (w >= nrows * G) return;
    const int r = w / G, gi = w % G;
    const float* p = in + (size_t)r * ld_in + gi * gs_in;
    float v = lane < 32 ? p[lane] : 0.f;
    const float s = wave_sum(v * v);
    const float rs = rsqrtf(s / 32.f + 1e-6f);
    v = lane < 32 ? v * rs * g[lane] : 0.f;
    const float x1 = __shfl(v, lane & 15), x2 = __shfl(v, (lane & 15) + 16);
    const int j = lane & 15;
    const float inv_freq = powf(10000.0f, -(float)j / 16.0f);
    const float ang = (float)pos[r] * inv_freq;
    const float c = cosf(ang), sn = sinf(ang);
    const float o = (lane < 16) ? (x1 * c - x2 * sn) : (x1 * sn + x2 * c);
    if (lane < 32) {
        if (nrep == 1) out[(size_t)r * ld_out + gi * gs_out + lane] = o;
        else for (int rep = 0; rep < nrep; ++rep) out[(size_t)r * ld_out + rep * gs_out + lane] = o;
    }
}

__global__ __launch_bounds__(256) void bl_gemm(const float* A, int lda, const float* B, int ldb, float* C, int ldc, int M, int N, int K, int accum) {
    __shared__ float As[16][65];
    __shared__ float Bs[16][65];
    const int tx = threadIdx.x & 15, ty = threadIdx.x >> 4;
    const int m0 = blockIdx.y * 64, n0 = blockIdx.x * 64;
    float acc00 = 0, acc01 = 0, acc02 = 0, acc03 = 0, acc10 = 0, acc11 = 0, acc12 = 0, acc13 = 0, acc20 = 0, acc21 = 0, acc22 = 0, acc23 = 0, acc30 = 0, acc31 = 0, acc32 = 0, acc33 = 0;
    for (int k0 = 0; k0 < K; k0 += 16) {
#pragma unroll
        for (int ii = 0; ii < 4; ++ii) { const int i = threadIdx.x + ii * 256; const int r = i >> 4, c = i & 15; const int gm = m0 + r; As[c][r] = gm < M ? A[(size_t)gm * lda + k0 + c] : 0.f; }
#pragma unroll
        for (int ii = 0; ii < 4; ++ii) { const int i = threadIdx.x + ii * 256; const int r = i >> 6, c = i & 63; const int gn = n0 + c; Bs[r][c] = gn < N ? B[(size_t)(k0 + r) * ldb + gn] : 0.f; }
        __syncthreads();
#pragma unroll
        for (int kk = 0; kk < 16; ++kk) {
            const float a0 = As[kk][ty * 4 + 0], a1 = As[kk][ty * 4 + 1], a2 = As[kk][ty * 4 + 2], a3 = As[kk][ty * 4 + 3];
            const float b0 = Bs[kk][tx * 4 + 0], b1 = Bs[kk][tx * 4 + 1], b2 = Bs[kk][tx * 4 + 2], b3 = Bs[kk][tx * 4 + 3];
            acc00 += a0 * b0; acc01 += a0 * b1; acc02 += a0 * b2; acc03 += a0 * b3;
            acc10 += a1 * b0; acc11 += a1 * b1; acc12 += a1 * b2; acc13 += a1 * b3;
            acc20 += a2 * b0; acc21 += a2 * b1; acc22 += a2 * b2; acc23 += a2 * b3;
            acc30 += a3 * b0; acc31 += a3 * b1; acc32 += a3 * b2; acc33 += a3 * b3;
        }
        __syncthreads();
    }
#define BL_ST(i, j, v) do { const int gm = m0 + ty * 4 + (i), gn = n0 + tx * 4 + (j); if (gm < M && gn < N) { float* cp = C + (size_t)gm * ldc + gn; *cp = accum ? (*cp + (v)) : (v); } } while (0)
    BL_ST(0, 0, acc00); BL_ST(0, 1, acc01); BL_ST(0, 2, acc02); BL_ST(0, 3, acc03);
    BL_ST(1, 0, acc10); BL_ST(1, 1, acc11); BL_ST(1, 2, acc12); BL_ST(1, 3, acc13);
    BL_ST(2, 0, acc20); BL_ST(2, 1, acc21); BL_ST(2, 2, acc22); BL_ST(2, 3, acc23);
    BL_ST(3, 0, acc30); BL_ST(3, 1, acc31); BL_ST(3, 2, acc32); BL_ST(3, 3, acc33);
#undef BL_ST
}

__device__ __forceinline__ float log_sigmoid_f(float x) { return fminf(x, 0.f) - log1pf(expf(-fabsf(x))); }

__global__ void bl_cum(const float* H, const float* bf, float* cum) {
    const int h = threadIdx.x; if (h >= 8) return;
    float c = 0.f;
    for (int t = 0; t < SEQ; ++t) { c += log_sigmoid_f(H[(size_t)t * D_IN + OFF_F + h] + bf[h]); cum[t * 8 + h] = c; }
}

template <int DK> __global__ __launch_bounds__(256) void bl_attn_causal(const float* Q, int ldq, const float* Kp, int ldk, const float* V, int ldv, int vgs, float* O, const float* cum, float scale) {
    const int w = blockIdx.x * 4 + (threadIdx.x >> 6), lane = threadIdx.x & 63;
    const int t = w >> 3, h = w & 7;
    const float* q = Q + (size_t)t * ldq + h * DK;
    const float q0 = q[lane];
    float q1 = 0.f; if (DK > 64 && lane < DK - 64) q1 = q[64 + lane];
    float m = -INFINITY, den = 0.f, o = 0.f;
    const float cq = cum ? cum[t * 8 + h] : 0.f;
    for (int j = 0; j <= t; ++j) {
        const float* kr = Kp + (size_t)j * ldk + h * DK;
        float s = q0 * kr[lane];
        if (DK > 64 && lane < DK - 64) s += q1 * kr[64 + lane];
        s = wave_sum(s) * scale;
        if (cum) s = (s + cq) - cum[j * 8 + h];
        const float mn = fmaxf(m, s);
        const float a = expf(m - mn), p = expf(s - mn);
        den = den * a + p; o = o * a + p * V[(size_t)j * ldv + h * vgs + lane]; m = mn;
    }
    O[(size_t)t * 512 + h * 64 + lane] = o / den;
}

__global__ __launch_bounds__(256) void bl_attn_dil(const float* Q, const float* Kp, const float* V, int ldv, const float* rel_bias, float* O) {
    const int w = blockIdx.x * 4 + (threadIdx.x >> 6), lane = threadIdx.x & 63;
    const int t = w >> 3, h = w & 7;
    const float q = Q[(size_t)t * 512 + h * 64 + lane];
    float o0 = 0, o1 = 0, o2 = 0, l0 = 0, l1 = 0, l2 = 0;
#pragma unroll
    for (int br = 0; br < 3; ++br) {
        const int dil = br == 0 ? 1 : (br == 1 ? 4 : 16);
        const int i = t / dil;
        float m = -INFINITY, den = 0.f, o = 0.f;
        for (int dist = 0; dist <= 128 && dist <= i; ++dist) {
            const int tk = t - dist * dil;
            float s = wave_sum(q * Kp[(size_t)tk * 512 + h * 64 + lane]) / 8.0f + rel_bias[(int)T5B[br][dist] * 8 + h];
            const float mn = fmaxf(m, s);
            const float a = expf(m - mn), p = expf(s - mn);
            den = den * a + p; o = o * a + p * V[(size_t)tk * ldv + h * 64 + lane]; m = mn;
        }
        const float ob = o / den, lse = m + logf(den);
        if (br == 0) { o0 = ob; l0 = lse; } else if (br == 1) { o1 = ob; l1 = lse; } else { o2 = ob; l2 = lse; }
    }
    const float mx = fmaxf(l0, fmaxf(l1, l2));
    const float w0 = expf(l0 - mx), w1 = expf(l1 - mx), w2 = expf(l2 - mx);
    const float ws = w0 + w1 + w2;
    O[(size_t)t * 512 + h * 64 + lane] = (o0 * w0 + o1 * w1 + o2 * w2) / ws;
}

__global__ __launch_bounds__(256) void bl_gate_merge(const float* H, const float* P0, const float* P1, const float* P2, float* Mb) {
    const size_t i = (size_t)blockIdx.x * 256 + threadIdx.x;
    const size_t t = i >> 10; const int d = (int)(i & 1023);
    const float* hg = H + t * D_IN + OFF_G + d;
    const float g0 = 1.f / (1.f + expf(-hg[0])), g1 = 1.f / (1.f + expf(-hg[1024])), g2 = 1.f / (1.f + expf(-hg[2048]));
    Mb[i] = g0 * P0[i] + g1 * P1[i] + g2 * P2[i];
}

__global__ __launch_bounds__(256) void bl_moe(float* x, const float* gn, const float* wrg, const float* brg, const float* wre, const float* bre,
                                              const float* wg, const float* wu, const float* wd) {
    __shared__ float xs[1024];
    __shared__ float red[4];
    __shared__ float logits[20];
    __shared__ float hid[256];
    const int t = blockIdx.x, tid = threadIdx.x, wv = tid >> 6, lane = tid & 63;
    float* xr = x + (size_t)t * 1024;
    const float v0 = xr[tid], v1 = xr[tid + 256], v2 = xr[tid + 512], v3 = xr[tid + 768];
    float ss = wave_sum(v0 * v0 + v1 * v1 + v2 * v2 + v3 * v3);
    if (lane == 0) red[wv] = ss;
    __syncthreads();
    ss = red[0] + red[1] + red[2] + red[3];
    const float rs = rsqrtf(ss / 1024.f + 1e-6f);
    xs[tid] = v0 * rs * gn[tid]; xs[tid + 256] = v1 * rs * gn[tid + 256]; xs[tid + 512] = v2 * rs * gn[tid + 512]; xs[tid + 768] = v3 * rs * gn[tid + 768];
    __syncthreads();
    for (int o = wv; o < 20; o += 4) {
        float a = 0.f;
        if (o < 4) { for (int k = lane; k < 1024; k += 64) a += xs[k] * wrg[k * 4 + o]; }
        else { for (int k = lane; k < 1024; k += 64) a += xs[k] * wre[k * 16 + (o - 4)]; }
        a = wave_sum(a);
        if (lane == 0) logits[o] = a + (o < 4 ? brg[o] : bre[o - 4]);
    }
    __syncthreads();
    const float g0 = logits[0], g1 = logits[1], g2 = logits[2], g3 = logits[3];
    const float gm = fmaxf(fmaxf(g0, g1), fmaxf(g2, g3));
    const float p0 = expf(g0 - gm), p1 = expf(g1 - gm), p2 = expf(g2 - gm), p3 = expf(g3 - gm);
    const float ps = p0 + p1 + p2 + p3;
    int gi = 0; float pb = p0;
    if (p1 > pb) { pb = p1; gi = 1; }
    if (p2 > pb) { pb = p2; gi = 2; }
    if (p3 > pb) { pb = p3; gi = 3; }
    const float pg_top = pb / ps;
    const float e0 = logits[4 + gi * 4 + 0], e1 = logits[4 + gi * 4 + 1], e2 = logits[4 + gi * 4 + 2], e3 = logits[4 + gi * 4 + 3];
    int i0 = 0; float b0 = e0;
    if (e1 > b0) { b0 = e1; i0 = 1; }
    if (e2 > b0) { b0 = e2; i0 = 2; }
    if (e3 > b0) { b0 = e3; i0 = 3; }
    int i1 = -1; float b1 = -INFINITY;
    if (i0 != 0 && e0 > b1) { b1 = e0; i1 = 0; }
    if (i0 != 1 && e1 > b1) { b1 = e1; i1 = 1; }
    if (i0 != 2 && e2 > b1) { b1 = e2; i1 = 2; }
    if (i0 != 3 && e3 > b1) { b1 = e3; i1 = 3; }
    const float ex1 = expf(b1 - b0);
    const float we0 = 1.f / (1.f + ex1) * pg_top, we1 = ex1 / (1.f + ex1) * pg_top;
    float y0 = 0, y1 = 0, y2 = 0, y3 = 0;
    for (int kk = 0; kk < 2; ++kk) {
        const int e = gi * 4 + (kk == 0 ? i0 : i1);
        const float wgt = kk == 0 ? we0 : we1;
        const float* Wg = wg + (size_t)e * 1024 * 256; const float* Wu = wu + (size_t)e * 1024 * 256; const float* Wd = wd + (size_t)e * 256 * 1024;
        float a = 0.f, u = 0.f;
        for (int k = 0; k < 1024; ++k) { const float xv = xs[k]; a += xv * Wg[k * 256 + tid]; u += xv * Wu[k * 256 + tid]; }
        hid[tid] = a / (1.f + expf(-a)) * u;
        __syncthreads();
        float z0 = 0, z1 = 0, z2 = 0, z3 = 0;
        for (int j = 0; j < 256; ++j) { const float hv = hid[j]; const float* wr = Wd + (size_t)j * 1024 + tid; z0 += hv * wr[0]; z1 += hv * wr[256]; z2 += hv * wr[512]; z3 += hv * wr[768]; }
        y0 += wgt * z0; y1 += wgt * z1; y2 += wgt * z2; y3 += wgt * z3;
        __syncthreads();
    }
    xr[tid] = v0 + y0; xr[tid + 256] = v1 + y1; xr[tid + 512] = v2 + y2; xr[tid + 768] = v3 + y3;
}

extern "C" void kernel_launch(void* const* d_in, const int* in_sizes, int n_in, void* d_out, int out_size, void* d_ws, size_t ws_size, hipStream_t stream) {
    const float* x_in = (const float*)d_in[0];
    const int* positions = (const int*)d_in[1];
    const float* rel_bias = (const float*)d_in[2];
    const float* norm_mix = (const float*)d_in[3];
    const float* w_in = (const float*)d_in[4];
    const float* b_forget = (const float*)d_in[5];
    const float* gq_a = (const float*)d_in[6];
    const float* gk_a = (const float*)d_in[7];
    const float* gq_b = (const float*)d_in[8];
    const float* gk_b = (const float*)d_in[9];
    const float* gq_c = (const float*)d_in[10];
    const float* gk_c = (const float*)d_in[11];
    const float* norm_cq = (const float*)d_in[12];
    const float* norm_ckv = (const float*)d_in[13];
    const float* w_uq = (const float*)d_in[14];
    const float* w_ukv = (const float*)d_in[15];
    const float* w_branch = (const float*)d_in[16];
    const float* w_out = (const float*)d_in[17];
    const float* norm_ffn = (const float*)d_in[18];
    const float* w_rg = (const float*)d_in[19];
    const float* b_rg = (const float*)d_in[20];
    const float* w_re = (const float*)d_in[21];
    const float* b_re = (const float*)d_in[22];
    const float* w_eg = (const float*)d_in[23];
    const float* w_eu = (const float*)d_in[24];
    const float* w_ed = (const float*)d_in[25];
    float* x = (float*)d_out;
    hipMemcpyAsync(x, x_in, (size_t)T_ALL * D_MODEL * sizeof(float), hipMemcpyDeviceToDevice, stream);

    float* ws = (float*)d_ws;
    size_t off = 0;
    auto carve = [&](size_t n) { float* p = ws + off; off += (n + 63) & ~(size_t)63; return p; };
    float* XN = carve((size_t)SEQ * 1024);
    float* H = carve((size_t)SEQ * D_IN);
    float* QA = carve((size_t)SEQ * 512); float* KA = carve((size_t)SEQ * 512);
    float* QB = carve((size_t)SEQ * 512); float* KB = carve((size_t)SEQ * 512);
    float* CUM = carve((size_t)SEQ * 8);
    float* CQN = carve((size_t)SEQ * 256); float* QC = carve((size_t)SEQ * 768);
    float* CKVN = carve((size_t)SEQ * 128); float* KVC = carve((size_t)SEQ * 1024);
    float* QF = carve((size_t)SEQ * 768); float* KF = carve((size_t)SEQ * 768);
    float* OA = carve((size_t)SEQ * 512); float* OB = carve((size_t)SEQ * 512); float* OC = carve((size_t)SEQ * 512);
    float* PR0 = carve((size_t)SEQ * 1024); float* PR1 = carve((size_t)SEQ * 1024); float* PR2 = carve((size_t)SEQ * 1024);
    float* MB = carve((size_t)SEQ * 1024);

    auto gemm = [&](const float* A, int lda, const float* B, int ldb, float* C, int ldc, int M, int N, int K, int accum) {
        dim3 g((N + 63) / 64, (M + 63) / 64);
        hipLaunchKernelGGL(bl_gemm, g, dim3(256), 0, stream, A, lda, B, ldb, C, ldc, M, N, K, accum);
    };
    auto rms = [&](const float* in, int ld_in, int gs_in, const float* g, float* out, int ld_out, int gs_out, int nrows, int G, int nc) {
        hipLaunchKernelGGL(bl_rms, dim3((nrows * G + 3) / 4), dim3(256), 0, stream, in, ld_in, gs_in, g, out, ld_out, gs_out, nrows, G, nc);
    };
    for (int l = 0; l < DEPTH; ++l) {
        for (int b = 0; b < BATCH; ++b) {
            float* xb = x + (size_t)b * SEQ * 1024;
            const int* pos = positions + b * SEQ;
            rms(xb, 1024, 0, norm_mix + l * 1024, XN, 1024, 0, SEQ, 1, 1024);
            gemm(XN, 1024, w_in + (size_t)l * 1024 * D_IN, D_IN, H, D_IN, SEQ, D_IN, 1024, 0);
            rms(H + OFF_A, D_IN, 64, gq_a + l * 64, QA, 512, 64, SEQ, 8, 64);
            rms(H + OFF_A + 512, D_IN, 64, gk_a + l * 64, KA, 512, 64, SEQ, 8, 64);
            hipLaunchKernelGGL(bl_attn_dil, dim3(SEQ * 8 / 4), dim3(256), 0, stream, (const float*)QA, (const float*)KA, (const float*)(H + OFF_A + 1024), D_IN, rel_bias, OA);
            rms(H + OFF_B, D_IN, 64, gq_b + l * 64, QB, 512, 64, SEQ, 8, 64);
            rms(H + OFF_B + 512, D_IN, 64, gk_b + l * 64, KB, 512, 64, SEQ, 8, 64);
            hipLaunchKernelGGL(bl_cum, dim3(1), dim3(64), 0, stream, (const float*)H, b_forget + l * 8, CUM);
            hipLaunchKernelGGL(bl_attn_causal<64>, dim3(SEQ * 8 / 4), dim3(256), 0, stream, (const float*)QB, 512, (const float*)KB, 512, (const float*)(H + OFF_B + 1024), D_IN, 64, OB, (const float*)CUM, 0.125f);
            rms(H + OFF_CQ, D_IN, 0, norm_cq + l * 256, CQN, 256, 0, SEQ, 1, 256);
            gemm(CQN, 256, w_uq + (size_t)l * 256 * 768, 768, QC, 768, SEQ, 768, 256, 0);
            rms(H + OFF_CKV, D_IN, 0, norm_ckv + l * 128, CKVN, 128, 0, SEQ, 1, 128);
            gemm(CKVN, 128, w_ukv + (size_t)l * 128 * 1024, 1024, KVC, 1024, SEQ, 1024, 128, 0);
            rms(QC, 768, 96, gq_c + l * 96, QF, 768, 96, SEQ, 8, 64);
            hipLaunchKernelGGL(bl_rope, dim3(SEQ * 8 / 4), dim3(256), 0, stream, (const float*)(QC + 64), 768, 96, gq_c + l * 96 + 64, pos, QF + 64, 768, 96, SEQ, 8, 1);
            rms(KVC, 1024, 128, gk_c + l * 96, KF, 768, 96, SEQ, 8, 64);
            hipLaunchKernelGGL(bl_rope, dim3(SEQ / 4), dim3(256), 0, stream, (const float*)(H + OFF_KR), D_IN, 0, gk_c + l * 96 + 64, pos, KF + 64, 768, 96, SEQ, 1, 8);
            hipLaunchKernelGGL(bl_attn_causal<96>, dim3(SEQ * 8 / 4), dim3(256), 0, stream, (const float*)QF, 768, (const float*)KF, 768, (const float*)(KVC + 64), 1024, 128, OC, (const float*)nullptr, 0.10206207261596577f);
            gemm(OA, 512, w_branch + ((size_t)l * 3 + 0) * 512 * 1024, 1024, PR0, 1024, SEQ, 1024, 512, 0);
            gemm(OB, 512, w_branch + ((size_t)l * 3 + 1) * 512 * 1024, 1024, PR1, 1024, SEQ, 1024, 512, 0);
            gemm(OC, 512, w_branch + ((size_t)l * 3 + 2) * 512 * 1024, 1024, PR2, 1024, SEQ, 1024, 512, 0);
            hipLaunchKernelGGL(bl_gate_merge, dim3(SEQ * 1024 / 256), dim3(256), 0, stream, (const float*)H, (const float*)PR0, (const float*)PR1, (const float*)PR2, MB);
            gemm(MB, 1024, w_out + (size_t)l * 1024 * 1024, 1024, xb, 1024, SEQ, 1024, 1024, 1);
        }
        hipLaunchKernelGGL(bl_moe, dim3(T_ALL), dim3(256), 0, stream, x, norm_ffn + l * 1024, w_rg + (size_t)l * 1024 * 4, b_rg + l * 4, w_re + (size_t)l * 1024 * 16, b_re + l * 16,
                           w_eg + (size_t)l * 16 * 1024 * 256, w_eu + (size_t)l * 16 * 1024 * 256, w_ed + (size_t)l * 16 * 256 * 1024);
    }
}
```

```cpp
#include <hip/hip_runtime.h>
#include <cstdint>
#include <cstdio>

#define LAS __attribute__((address_space(3)))
#define GAS __attribute__((address_space(1)))
typedef unsigned short bf16_t;
typedef short bf16x8 __attribute__((ext_vector_type(8)));
typedef short s16x4 __attribute__((ext_vector_type(4)));
typedef float f32x2 __attribute__((ext_vector_type(2)));
typedef float f32x4 __attribute__((ext_vector_type(4)));
typedef float f32x16 __attribute__((ext_vector_type(16)));
typedef unsigned u32x2 __attribute__((ext_vector_type(2)));
typedef unsigned u32x4 __attribute__((ext_vector_type(4)));

constexpr int T = 32768, SEQ = 2048, NBATCH = 16, DM = 1024, NLAYER = 4, D_IN = 6568;
constexpr int OFF_A = 0, OFF_B = 1536, OFF_F = 3072, OFF_CQ = 3080, OFF_CKV = 3336, OFF_KR = 3464, OFF_G = 3496;
constexpr float LOG2E = 1.4426950408889634f;
constexpr float C2_64 = 0.125f * 1.4426950408889634f;
constexpr float C2_96 = 0.10206207261596577f * 1.4426950408889634f;
constexpr float EPS = 1e-6f;

__constant__ unsigned char T5B[3][129] = {
{0,1,2,3,4,5,6,7,8,9,10,11,12,13,14,15,16,16,16,16,16,16,17,17,17,17,17,17,17,17,18,18,18,18,18,18,18,18,18,18,19,19,19,19,19,19,19,19,19,19,19,19,19,19,20,20,20,20,20,20,20,20,20,20,20,20,20,20,20,20,20,20,20,21,21,21,21,21,21,21,21,21,21,21,21,21,21,21,21,21,21,21,21,21,21,21,21,21,21,22,22,22,22,22,22,22,22,22,22,22,22,22,22,22,22,22,22,22,22,22,22,22,22,22,22,22,22,22,22},
{0,4,8,12,16,16,17,17,18,18,19,19,19,19,20,20,20,20,20,21,21,21,21,21,21,22,22,22,22,22,22,22,22,22,23,23,23,23,23,23,23,23,23,23,23,23,24,24,24,24,24,24,24,24,24,24,24,24,24,24,24,24,25,25,25,25,25,25,25,25,25,25,25,25,25,25,25,25,25,25,25,25,25,26,26,26,26,26,26,26,26,26,26,26,26,26,26,26,26,26,26,26,26,26,26,26,26,26,26,26,26,26,26,27,27,27,27,27,27,27,27,27,27,27,27,27,27,27,27},
{0,16,18,19,20,21,21,22,22,23,23,23,24,24,24,24,25,25,25,25,25,26,26,26,26,26,26,26,26,27,27,27,27,27,27,27,27,27,27,28,28,28,28,28,28,28,28,28,28,28,28,28,29,29,29,29,29,29,29,29,29,29,29,29,29,29,29,29,29,29,30,30,30,30,30,30,30,30,30,30,30,30,30,30,30,30,30,30,30,30,30,30,30,30,30,31,31,31,31,31,31,31,31,31,31,31,31,31,31,31,31,31,31,31,31,31,31,31,31,31,31,31,31,31,31,31,31,31,31}};

constexpr size_t MiB = (size_t)1 << 20;
constexpr size_t WS_CTL = 0, CTL_ZERO_BYTES = 1 * MiB;
constexpr size_t WS_RSTD1 = 1 * MiB;
constexpr size_t WS_RSTD2 = 1 * MiB + 256 * 1024;
constexpr size_t WS_XPART = 2 * MiB;
constexpr size_t WS_CQP = 4 * MiB;
constexpr size_t WS_CKVP = 4 * MiB + 512 * 1024;
constexpr size_t WS_LOGF = 5 * MiB;
constexpr size_t WS_CUM = 6 * MiB;
constexpr size_t WS_LSE = 7 * MiB;
constexpr size_t WS_RCLS = 8 * MiB;
constexpr size_t WS_RW0 = 8 * MiB + 256 * 1024;
constexpr size_t WS_RW1 = 8 * MiB + 512 * 1024;
constexpr size_t WS_GTAB = 8 * MiB + 768 * 1024;
constexpr size_t WS_PERM = 9 * MiB;
constexpr size_t WS_KROPE = 12 * MiB;
constexpr size_t WS_COS = 14 * MiB;
constexpr size_t WS_SIN = 16 * MiB;
constexpr size_t WS_WIN = 18 * MiB;
constexpr size_t WS_WUQ = 31 * MiB;
constexpr size_t WS_WUKV = 31 * MiB + 512 * 1024;
constexpr size_t WS_WBR = 32 * MiB;
constexpr size_t WS_WOUT = 35 * MiB;
constexpr size_t WS_WGU = 37 * MiB;
constexpr size_t WS_WD = 53 * MiB;
constexpr size_t WS_XB = 64 * MiB;
constexpr size_t WS_QA = 128 * MiB, WS_KA = 160 * MiB, WS_VA = 192 * MiB, WS_QB = 224 * MiB, WS_KB = 256 * MiB, WS_VB = 288 * MiB;
constexpr size_t WS_HCQ = 320 * MiB;
constexpr size_t WS_HCKV = 336 * MiB;
constexpr size_t WS_QNOPE = 344 * MiB;
constexpr size_t WS_QROPE = 376 * MiB;
constexpr size_t WS_KNOPE = 392 * MiB;
constexpr size_t WS_VC = 424 * MiB;
constexpr size_t WS_OA = 456 * MiB;
constexpr size_t WS_END = 488 * MiB;
constexpr size_t WS_GSCR = WS_QA;
constexpr size_t WS_MACC = WS_KB;
constexpr size_t WS_MBUF = WS_KA;
constexpr size_t WS_HID = WS_VB;
constexpr int CW_BAR = 4096;
constexpr int CW_CNT = 16384;

constexpr int RING_BYTES = 131072;
constexpr int MISC_OFF = RING_BYTES;
constexpr int LDS_BYTES = 147456;

__device__ __forceinline__ unsigned f2bf(float f) { unsigned u = __builtin_bit_cast(unsigned, f); return (u + 0x7fffu + ((u >> 16) & 1u)) >> 16; }
__device__ __forceinline__ unsigned pk2(float lo, float hi) { typedef __bf16 bf16x2_t __attribute__((ext_vector_type(2))); f32x2 v = {lo, hi}; bf16x2_t b = __builtin_convertvector(v, bf16x2_t); return __builtin_bit_cast(unsigned, b); }
__device__ __forceinline__ float bf2f(unsigned short h) { return __builtin_bit_cast(float, (unsigned)h << 16); }
__device__ __forceinline__ float bflo(unsigned w) { return __builtin_bit_cast(float, w << 16); }
__device__ __forceinline__ float bfhi(unsigned w) { return __builtin_bit_cast(float, w & 0xffff0000u); }
__device__ __forceinline__ float wave_sum(float v) {
#pragma unroll
    for (int o = 1; o < 64; o <<= 1) v += __shfl_xor(v, o);
    return v;
}
__device__ __forceinline__ float fast_exp2(float x) { return __builtin_amdgcn_exp2f(x); }
__device__ __forceinline__ float fast_log2(float x) { return __builtin_amdgcn_logf(x); }
__device__ __forceinline__ float sigmoid_f(float x) { return 1.0f / (1.0f + __expf(-x)); }
__device__ __forceinline__ float log_sigmoid_f(float x) { return fminf(x, 0.f) - log1pf(expf(-fabsf(x))); }
__device__ __forceinline__ int fresh_tid() { int t = threadIdx.x; asm volatile("" : "+v"(t)); return t; }
#define LDS_WAIT() asm volatile("s_waitcnt lgkmcnt(0)" ::: "memory")
#define VM_WAIT() asm volatile("s_waitcnt vmcnt(0)" ::: "memory")

#define XB_TMO      128
#define XB_XCNT(j)  (256  + 64 * (j))
#define XB_XSUB(j)  (1280 + 64 * (j))
#define XB_XGEN(j)  (2304 + 64 * (j))
#define XB_TOP      3328
#define XB_TOPGEN   3392
#define XCD_BAR_WORDS 3456
#define XB_SPIN_CAP (1u << 24)
__device__ __forceinline__ unsigned xb_ld(unsigned* p)              { return __hip_atomic_load(p, __ATOMIC_RELAXED, __HIP_MEMORY_SCOPE_AGENT); }
__device__ __forceinline__ unsigned xb_add(unsigned* p, unsigned v) { return __hip_atomic_fetch_add(p, v, __ATOMIC_RELAXED, __HIP_MEMORY_SCOPE_AGENT); }
__device__ __forceinline__ unsigned xb_xcc_id() { return (unsigned)__builtin_amdgcn_s_getreg((3 << 11) | 20) & 0xFu; }
#define XB_SPIN(cond, bar) do { unsigned _sp = 0; while (cond) { __builtin_amdgcn_s_sleep(1); \
    if ((++_sp & 255u) == 0u) { if (xb_ld(&(bar)[XB_TMO])) break; if (_sp > XB_SPIN_CAP) { atomicAdd(&(bar)[XB_TMO], 1u); break; } } } } while (0)
struct XcdBarrier { unsigned* bar; unsigned x; volatile LAS unsigned* st; };
__device__ __forceinline__ XcdBarrier xcd_barrier_post(unsigned* bar, volatile LAS unsigned* st) {
    XcdBarrier b; b.bar = bar; b.x = xb_xcc_id(); b.st = st;
    if (threadIdx.x == 0) (void)xb_add(&bar[XB_XCNT(b.x)], 1u);
    return b;
}
__device__ __forceinline__ void xcd_barrier_complete(unsigned* bar, unsigned x, unsigned& nloc, unsigned& nx) {
    const unsigned G = gridDim.x * gridDim.y * gridDim.z;
    unsigned sum, cnt, mine, sp = 0u;
    for (;;) {
        sum = 0u; cnt = 0u; mine = 0u;
#pragma unroll
        for (unsigned j = 0; j < 16; ++j) { const unsigned c = xb_ld(&bar[XB_XCNT(j)]); sum += c; cnt += (c > 0u) ? 1u : 0u; mine = (j == x) ? c : mine; }
        if (sum == G) break;
        __builtin_amdgcn_s_sleep(1);
        if ((++sp & 255u) == 0u) { if (xb_ld(&bar[XB_TMO])) break; if (sp > XB_SPIN_CAP) { atomicAdd(&bar[XB_TMO], 1u); break; } }
    }
    nloc = mine > 0u ? mine : 1u; nx = cnt > 0u ? cnt : 1u;
}
__device__ __forceinline__ void xcd_barrier(const XcdBarrier& b) {
    asm volatile("s_waitcnt vmcnt(0)" ::: "memory");
    __syncthreads();
    if (threadIdx.x == 0) {
        unsigned* bar = b.bar; unsigned bx_ = b.x;
        asm volatile("" : "+s"(bar), "+s"(bx_));
        __builtin_amdgcn_s_waitcnt(0);
        unsigned nloc = b.st[0], nx = b.st[1];
        if (nloc == 0u) { xcd_barrier_complete(bar, bx_, nloc, nx); b.st[0] = nloc; b.st[1] = nx; }
        const unsigned old = xb_add(&bar[XB_XSUB(bx_)], 1u);
        const unsigned gen = old / nloc;
        if (old + 1u == (gen + 1u) * nloc) {
            __builtin_amdgcn_fence(__ATOMIC_RELEASE, "agent");
            asm volatile("s_waitcnt vmcnt(0)" ::: "memory");
            const unsigned og = xb_add(&bar[XB_TOP], 1u);
            const unsigned tg = og / nx;
            if (og + 1u == (tg + 1u) * nx) xb_add(&bar[XB_TOPGEN], 1u);
            else XB_SPIN(xb_ld(&bar[XB_TOPGEN]) == tg, bar);
            __builtin_amdgcn_fence(__ATOMIC_ACQUIRE, "agent");
            xb_add(&bar[XB_XGEN(bx_)], 1u);
            asm volatile("s_waitcnt vmcnt(0)" ::: "memory");
        } else {
            XB_SPIN(xb_ld(&bar[XB_XGEN(bx_)]) == gen, bar);
            __builtin_amdgcn_fence(__ATOMIC_ACQUIRE, "agent");
            asm volatile("s_waitcnt vmcnt(0)" ::: "memory");
        }
    }
    __syncthreads();
}

namespace g8 {
constexpr int BM = 256, BK = 64, HALF = 128, HTB = HALF * BK * 2, STAGE_BYTES = 8 * HTB;
__device__ __forceinline__ int lds_byte(int r, int c) { const int st = (r >> 4) * 2 + (c >> 5), rr = r & 15, cc = c & 31, ob = rr * 64 + cc * 2; return st * 1024 + (ob ^ (((ob >> 9) & 1) << 5)); }
__device__ __forceinline__ void stage_rc(int b, int& R, int& C) { const int st = b / 1024, sb = b % 1024, swz = sb ^ (((sb >> 9) & 1) << 5); R = (st >> 1) * 16 + swz / 64; C = (st & 1) * 32 + (swz % 64) / 2; }
__device__ __forceinline__ int perm32(int rho) { const int n = rho >> 4, i = rho & 15; return 8 * (i >> 2) + 4 * n + (i & 3); }

struct GUnit {
    const char* A; const char* B;
    int lda2, ldb2;
    int nt;
    int pm, pn, kind, flags;
    const int* rows; int nvalid;
    int aux0, aux1, aux2;
};

template <class Epi, class Sched, bool GATHER>
__device__ __forceinline__ void gemm_run(LAS unsigned char* lds, const Sched& S, Epi& E) {
    const int tid = fresh_tid(), wid = __builtin_amdgcn_readfirstlane(tid >> 6), lane = tid & 63, wr = wid >> 2, wc = wid & 3, fr = lane & 15, fq = lane >> 4;
    int R0, C0, R1, C1; stage_rc(tid * 16, R0, C0); stage_rc(tid * 16 + 8192, R1, C1);
    const int Rb0 = (R0 & ~31) + perm32(R0 & 31), Rb1 = (R1 & ~31) + perm32(R1 & 31);
    unsigned C0x2 = (unsigned)C0 * 2u, C1x2 = (unsigned)C1 * 2u; asm volatile("" : "+v"(C0x2), "+v"(C1x2));
    const unsigned ldsw = (unsigned)wid * 1024u;
    const int aoff = lds_byte(wr * 64 + fr, fq * 8), boff = lds_byte(wc * 32 + fr, fq * 8);
#define G8_SA(b, h) (((b) * 2 + (h)) * HTB)
#define G8_SB(b, h) ((4 + (b) * 2 + (h)) * HTB)
#define G8_STAGE(bufoff, gbase, ld, ra, rb) do { \
        __builtin_amdgcn_global_load_lds((const unsigned*)((const char*)(gbase) + (__umul24((unsigned)(ra), (unsigned)(ld)) + C0x2)), (LAS unsigned*)(lds + (bufoff) + ldsw), 16, 0, 0); \
        __builtin_amdgcn_global_load_lds((const unsigned*)((const char*)(gbase) + (__umul24((unsigned)(rb), (unsigned)(ld)) + C1x2)), (LAS unsigned*)(lds + (bufoff) + ldsw + 8192), 16, 0, 0); } while (0)
#define G8_STAGE_G(bufoff, gbase, ga, gb) do { \
        __builtin_amdgcn_global_load_lds((const unsigned*)((const char*)(gbase) + (((unsigned)(ga) << 11) + C0x2)), (LAS unsigned*)(lds + (bufoff) + ldsw), 16, 0, 0); \
        __builtin_amdgcn_global_load_lds((const unsigned*)((const char*)(gbase) + (((unsigned)(gb) << 11) + C1x2)), (LAS unsigned*)(lds + (bufoff) + ldsw + 8192), 16, 0, 0); } while (0)
#define G8_STAGE_A(bufoff, pa, lda_, h, g0, g1) do { if (GATHER) G8_STAGE_G(bufoff, pa, g0, g1); else G8_STAGE(bufoff, (pa) + (size_t)(h) * 128 * (lda_), lda_, R0, R1); } while (0)
#define G8_STAGE_B(bufoff, pb, ldb_, h) G8_STAGE(bufoff, (pb) + (size_t)(h) * 128 * (ldb_), ldb_, Rb0, Rb1)
#define G8_LDA(dst, b, h) do { _Pragma("unroll") for (int m = 0; m < 4; ++m) _Pragma("unroll") for (int k = 0; k < 2; ++k) dst[m][k] = *(const LAS bf16x8*)(lds + G8_SA(b, h) + aoff + m * 2048 + k * 1024); } while (0)
#define G8_LDB(dst, b, h) do { _Pragma("unroll") for (int n = 0; n < 2; ++n) _Pragma("unroll") for (int k = 0; k < 2; ++k) dst[n][k] = *(const LAS bf16x8*)(lds + G8_SB(b, h) + boff + n * 2048 + k * 1024); } while (0)
#define G8_MMA(ai, bj, At, Bt) do { __builtin_amdgcn_s_setprio(1); _Pragma("unroll") for (int m = 0; m < 4; ++m) _Pragma("unroll") for (int n = 0; n < 2; ++n) _Pragma("unroll") for (int k = 0; k < 2; ++k) \
        acc[ai][bj][m][n] = __builtin_amdgcn_mfma_f32_16x16x32_bf16(Bt[n][k], At[m][k], acc[ai][bj][m][n], 0, 0, 0); __builtin_amdgcn_s_setprio(0); } while (0)
#define G8_WAIT_V(n) asm volatile("s_waitcnt vmcnt(" #n ")" ::: "memory")
#define G8_WAIT_L(n) asm volatile("s_waitcnt lgkmcnt(" #n ")" ::: "memory")
#define G8_BAR __builtin_amdgcn_s_barrier()
#define G8_SCHED __builtin_amdgcn_sched_barrier(0)
#define G8_ROWS(u, g00, g01, g10, g11) do { if (GATHER) { const int n_ = (u).nvalid; const int* rw_ = (u).rows; \
        g00 = (R0 < n_) ? rw_[R0] : 0; g01 = (R1 < n_) ? rw_[R1] : 0; g10 = (128 + R0 < n_) ? rw_[128 + R0] : 0; g11 = (128 + R1 < n_) ? rw_[128 + R1] : 0; } } while (0)
    GUnit cur, nxt; int ui = 0;
    if (!S.next(0, cur)) return;
    f32x4 acc[2][2][4][2];
#pragma unroll
    for (int a = 0; a < 2; ++a)
#pragma unroll
        for (int b = 0; b < 2; ++b)
#pragma unroll
            for (int m = 0; m < 4; ++m)
#pragma unroll
                for (int n = 0; n < 2; ++n) acc[a][b][m][n] = (f32x4){0.f, 0.f, 0.f, 0.f};
    bf16x8 At[4][2], B0[2][2], B1[2][2];
    int cg00 = 0, cg01 = 0, cg10 = 0, cg11 = 0, ng00 = 0, ng01 = 0, ng10 = 0, ng11 = 0;
    G8_ROWS(cur, cg00, cg01, cg10, cg11);
    const char* cA = cur.A; const char* cB = cur.B; int clda = cur.lda2, cldb = cur.ldb2;
    G8_STAGE_B(G8_SB(0, 0), cB, cldb, 0); G8_STAGE_B(G8_SB(0, 1), cB, cldb, 1); G8_STAGE_A(G8_SA(0, 0), cA, clda, 0, cg00, cg01); G8_STAGE_A(G8_SA(0, 1), cA, clda, 1, cg10, cg11);
    if (wr == 1) G8_BAR;
    G8_WAIT_V(2); G8_BAR;
    G8_STAGE_B(G8_SB(1, 0), cB + 128, cldb, 0); G8_STAGE_A(G8_SA(1, 0), cA + 128, clda, 0, cg00, cg01); G8_STAGE_B(G8_SB(1, 1), cB + 128, cldb, 1);
    G8_WAIT_V(6); G8_BAR;
    for (;;) {
        const bool has_next = S.next(ui + 1, nxt);
        const char* nA; const char* nB; int nlda, nldb;
        if (has_next) { nA = nxt.A; nB = nxt.B; nlda = nxt.lda2; nldb = nxt.ldb2; G8_ROWS(nxt, ng00, ng01, ng10, ng11); }
        else { nA = cA; nB = cB; nlda = clda; nldb = cldb; ng00 = cg00; ng01 = cg01; ng10 = cg10; ng11 = cg11; }
        const int nt = cur.nt;
        for (int t = 0; t < nt; t += 2) {
            const bool last = (t == nt - 2);
            asm volatile("" : "+v"(C0x2), "+v"(C1x2));
            const char* a1 = cA + (size_t)(t + 1) * 128;
            const char* a2 = last ? nA : cA + (size_t)(t + 2) * 128; const char* b2 = last ? nB : cB + (size_t)(t + 2) * 128;
            const char* a3 = a2 + 128; const char* b3 = b2 + 128;
            const int slda = last ? nlda : clda, sldb = last ? nldb : cldb;
            const int sg00 = last ? ng00 : cg00, sg01 = last ? ng01 : cg01, sg10 = last ? ng10 : cg10, sg11 = last ? ng11 : cg11;
            G8_LDB(B0, 0, 0); G8_LDB(B1, 0, 1); G8_SCHED; G8_LDA(At, 0, 0); G8_STAGE_A(G8_SA(1, 1), a1, clda, 1, cg10, cg11);
            G8_WAIT_V(8); G8_WAIT_L(0); G8_BAR; G8_MMA(0, 0, At, B0); G8_MMA(0, 1, At, B1); G8_BAR; G8_SCHED;
            G8_LDA(At, 0, 1); G8_STAGE_B(G8_SB(0, 0), b2, sldb, 0); G8_STAGE_B(G8_SB(0, 1), b2, sldb, 1); G8_STAGE_A(G8_SA(0, 0), a2, slda, 0, sg00, sg01);
            G8_WAIT_V(8); G8_WAIT_L(0); G8_BAR; G8_MMA(1, 0, At, B0); G8_MMA(1, 1, At, B1); G8_BAR; G8_SCHED;
            G8_LDB(B0, 1, 0); G8_LDB(B1, 1, 1); G8_SCHED; G8_LDA(At, 1, 0); G8_STAGE_A(G8_SA(0, 1), a2, slda, 1, sg10, sg11);
            G8_WAIT_V(8); G8_WAIT_L(0); G8_BAR; G8_MMA(0, 0, At, B0); G8_MMA(0, 1, At, B1); G8_BAR; G8_SCHED;
            G8_LDA(At, 1, 1); G8_STAGE_B(G8_SB(1, 0), b3, sldb, 0); G8_STAGE_B(G8_SB(1, 1), b3, sldb, 1); G8_STAGE_A(G8_SA(1, 0), a3, slda, 0, sg00, sg01);
            G8_WAIT_V(8); G8_WAIT_L(0); G8_BAR; G8_MMA(1, 0, At, B0); G8_MMA(1, 1, At, B1); G8_BAR; G8_SCHED;
        }
        if (wr == 0) G8_BAR;
        const bool noepi = (cur.flags & 1) != 0;
        if (!noepi) E(acc, cur, wr, wc, fr, fq);
        if (!has_next) break;
        if (!noepi) {
#pragma unroll
            for (int a = 0; a < 2; ++a)
#pragma unroll
                for (int b = 0; b < 2; ++b)
#pragma unroll
                    for (int m = 0; m < 4; ++m)
#pragma unroll
                        for (int n = 0; n < 2; ++n) acc[a][b][m][n] = (f32x4){0.f, 0.f, 0.f, 0.f};
        }
        cur = nxt; cA = nA; cB = nB; clda = nlda; cldb = nldb; ++ui;
        cg00 = ng00; cg01 = ng01; cg10 = ng10; cg11 = ng11;
        if (wr == 1) G8_BAR;
    }
    G8_WAIT_V(0);
    G8_BAR;
#undef G8_SA
#undef G8_SB
#undef G8_STAGE
#undef G8_STAGE_G
#undef G8_STAGE_A
#undef G8_STAGE_B
#undef G8_LDA
#undef G8_LDB
#undef G8_MMA
#undef G8_WAIT_V
#undef G8_WAIT_L
#undef G8_BAR
#undef G8_SCHED
#undef G8_ROWS
}
}
using g8::GUnit;

__device__ __forceinline__ bool static_tile(int L, int nM, int nN, int& pm, int& pn) {
    const int nwg = nM * nN; if (L >= nwg) return false;
    int wgid = L; { const int q = nwg / 8, r = nwg % 8, xcd = wgid % 8, off = wgid / 8; wgid = (xcd < r ? xcd * (q + 1) : r * (q + 1) + (xcd - r) * q) + off; }
    const int nig = 8 * nN, gid = wgid / nig, fm = gid * 8, gsz = (nM - fm) < 8 ? (nM - fm) : 8;
    pm = fm + ((wgid % nig) % gsz); pn = (wgid % nig) / gsz; return true;
}

struct Args { const void* in[26]; float* out; unsigned char* ws; };
struct Ctx {
    LAS unsigned char* lds; unsigned char* ws; float* out;
    int tid, lane, wave, vcu, G;
};
enum { IN_X = 0, IN_POS, IN_RELB, IN_NORM_MIX, IN_W_IN, IN_B_FORGET, IN_GQ_A, IN_GK_A, IN_GQ_B, IN_GK_B, IN_GQ_C, IN_GK_C, IN_NORM_CQ, IN_NORM_CKV, IN_W_UQ, IN_W_UKV, IN_W_BRANCH, IN_W_OUT, IN_NORM_FFN, IN_W_RG, IN_B_RG, IN_W_RE, IN_B_RE, IN_W_EG, IN_W_EU, IN_W_ED };
constexpr int ARGTAB_OFF = MISC_OFF + 2048;
__device__ __forceinline__ const float* argf(const Ctx& F, int k) {
    const unsigned long long v = *(const LAS unsigned long long*)(F.lds + ARGTAB_OFF + 8 * k);
    const unsigned lo = __builtin_amdgcn_readfirstlane((unsigned)v), hi = __builtin_amdgcn_readfirstlane((unsigned)(v >> 32));
    return (const float*)(((unsigned long long)hi << 32) | lo);
}
constexpr int MW_BAR = 8, MW_TCNT = 64, MW_TSTART = 96, MW_RCNT = 128, MW_RBASE = 160;

__device__ __forceinline__ void cvt_item(const float* src, int ld, int col0, int nvalid, const float* kscale, bf16_t* dst, int K, int n0, int k0, LAS float* scr, int lane) {
    const int n = lane & 31;
#pragma unroll 8
    for (int i = 0; i < 32; ++i) {
        const int kk = 2 * i + (lane >> 5);
        float v = 0.f;
        if (n < nvalid) { v = src[(size_t)(k0 + kk) * ld + col0 + n]; if (kscale) v *= kscale[k0 + kk]; }
        scr[kk * 33 + n] = v;
    }
    LDS_WAIT(); asm volatile("" ::: "memory");
    const int c = lane & 7;
#pragma unroll
    for (int j = 0; j < 4; ++j) {
        const int nn = (lane >> 3) + 8 * j; const LAS float* s = scr + (8 * c) * 33 + nn;
        u32x4 o; o.x = pk2(s[0 * 33], s[1 * 33]); o.y = pk2(s[2 * 33], s[3 * 33]); o.z = pk2(s[4 * 33], s[5 * 33]); o.w = pk2(s[6 * 33], s[7 * 33]);
        *(u32x4*)(dst + (size_t)(n0 + nn) * K + k0 + 8 * c) = o;
    }
    LDS_WAIT(); asm volatile("" ::: "memory");
}

__device__ __forceinline__ void phase_p0(Ctx& F, int l) {
    const int tid = fresh_tid(), lane = tid & 63, wave = __builtin_amdgcn_readfirstlane(tid >> 6);
    LAS float* scr = (LAS float*)(F.lds + wave * 8448);
    const int gw = F.vcu * 8 + wave, NGW = F.G * 8;
    unsigned char* ws = F.ws;
    constexpr int I_WIN = 208 * 16, I_UQ = 24 * 4, I_UKV = 32 * 2, I_BR = 3 * 32 * 8, I_OUT = 32 * 16, I_GU = 16 * 16 * 16, I_D = 16 * 32 * 4;
    constexpr int NITEMS = I_WIN + I_UQ + I_UKV + I_BR + I_OUT + I_GU + I_D;
    for (int it = gw; it < NITEMS; it += NGW) {
        int r = it;
        if (r < I_WIN) {
            const int nb = r >> 4, kb = r & 15, pn = nb >> 3, j = nb & 7, bj = j >> 2, wc = j & 3;
            int col0, nvalid = 32;
            if (pn < 12) { const int bi = pn >> 1, half = pn & 1; col0 = (bi < 3 ? OFF_A + bi * 512 : OFF_B + (bi - 3) * 512) + half * 256 + 64 * wc + 32 * bj; }
            else if (pn == 12) col0 = OFF_CQ + 64 * wc + 32 * bj;
            else if (pn == 13) { if (j < 4) col0 = OFF_CKV + 32 * j; else if (j == 4) col0 = OFF_KR; else if (j == 5) { col0 = OFF_F; nvalid = 8; } else { col0 = 0; nvalid = 0; } }
            else col0 = OFF_G + (pn - 14) * 256 + 32 * j;
            cvt_item(argf(F, IN_W_IN) + (size_t)l * 1024 * D_IN, D_IN, col0, nvalid, argf(F, IN_NORM_MIX) + l * 1024, (bf16_t*)(ws + WS_WIN), 1024, nb * 32, kb * 64, scr, lane);
            continue;
        }
        r -= I_WIN;
        if (r < I_UQ) {
            const int nb = r >> 2, kb = r & 3, tt = nb >> 3, j = nb & 7, bj = j >> 2, wc = j & 3;
            const int col0 = tt < 2 ? (4 * tt + wc) * 96 + 32 * bj : (4 * bj + wc) * 96 + 64;
            cvt_item(argf(F, IN_W_UQ) + (size_t)l * 256 * 768, 768, col0, 32, argf(F, IN_NORM_CQ) + l * 256, (bf16_t*)(ws + WS_WUQ), 256, nb * 32, kb * 64, scr, lane);
            continue;
        }
        r -= I_UQ;
        if (r < I_UKV) {
            const int nb = r >> 1, kb = r & 1, tt = nb >> 3, j = nb & 7, bj = j >> 2, wc = j & 3;
            const int col0 = tt < 2 ? (4 * tt + wc) * 128 + 32 * bj : (4 * (tt - 2) + wc) * 128 + 64 + 32 * bj;
            cvt_item(argf(F, IN_W_UKV) + (size_t)l * 128 * 1024, 1024, col0, 32, argf(F, IN_NORM_CKV) + l * 128, (bf16_t*)(ws + WS_WUKV), 128, nb * 32, kb * 64, scr, lane);
            continue;
        }
        r -= I_UKV;
        if (r < I_BR) {
            const int g = r >> 8, rr = r & 255, nb = rr >> 3, kb = rr & 7;
            cvt_item(argf(F, IN_W_BRANCH) + ((size_t)l * 3 + g) * 512 * 1024, 1024, nb * 32, 32, nullptr, (bf16_t*)(ws + WS_WBR) + (size_t)g * 1024 * 512, 512, nb * 32, kb * 64, scr, lane);
            continue;
        }
        r -= I_BR;
        if (r < I_OUT) {
            const int nb = r >> 4, kb = r & 15;
            cvt_item(argf(F, IN_W_OUT) + (size_t)l * 1024 * 1024, 1024, nb * 32, 32, nullptr, (bf16_t*)(ws + WS_WOUT), 1024, nb * 32, kb * 64, scr, lane);
            continue;
        }
        r -= I_OUT;
        if (r < I_GU) {
            const int e = r >> 8, rr = r & 255, nb = rr >> 4, kb = rr & 15, tt = nb >> 3, j = nb & 7, bj = j >> 2;
            const float* src = argf(F, bj == 0 ? IN_W_EG : IN_W_EU) + ((size_t)l * 16 + e) * 1024 * 256;
            cvt_item(src, 256, tt * 128 + 32 * (j & 3), 32, argf(F, IN_NORM_FFN) + l * 1024, (bf16_t*)(ws + WS_WGU) + (size_t)e * 512 * 1024, 1024, nb * 32, kb * 64, scr, lane);
            continue;
        }
        r -= I_GU;
        {
            const int e = r >> 7, rr = r & 127, nb = rr >> 2, kb = rr & 3;
            cvt_item(argf(F, IN_W_ED) + ((size_t)l * 16 + e) * 256 * 1024, 1024, nb * 32, 32, nullptr, (bf16_t*)(ws + WS_WD) + (size_t)e * 1024 * 256, 256, nb * 32, kb * 64, scr, lane);
        }
    }
    if (F.vcu == 0 && tid < 64) { float* gt = (float*)(ws + WS_GTAB); const int d = tid;
        gt[d] = argf(F, IN_GQ_A)[l * 64 + d] * C2_64; gt[64 + d] = argf(F, IN_GK_A)[l * 64 + d]; gt[128 + d] = argf(F, IN_GQ_B)[l * 64 + d] * C2_64; gt[192 + d] = argf(F, IN_GK_B)[l * 64 + d]; }
    float* rstd1 = (float*)(ws + WS_RSTD1);
    if (l == 0) {
        float* cosb = (float*)(ws + WS_COS); float* sinb = (float*)(ws + WS_SIN);
        const float* x_in = argf(F, IN_X); const int* positions = (const int*)argf(F, IN_POS);
        for (int m = gw; m < T; m += NGW) {
            const f32x4* xr = (const f32x4*)(x_in + (size_t)m * DM) + lane;
            f32x4 v[4]; float s = 0.f;
#pragma unroll
            for (int j = 0; j < 4; ++j) { v[j] = xr[64 * j]; s += (v[j].x * v[j].x + v[j].y * v[j].y) + (v[j].z * v[j].z + v[j].w * v[j].w); }
            s = wave_sum(s);
            if (lane == 0) rstd1[m] = rsqrtf(s * (1.f / DM) + EPS);
            f32x4* orow = (f32x4*)(F.out + (size_t)m * DM) + lane;
            u32x2* brow = (u32x2*)((bf16_t*)(ws + WS_XB) + (size_t)m * DM) + lane;
#pragma unroll
            for (int j = 0; j < 4; ++j) { orow[64 * j] = v[j]; u32x2 w; w.x = pk2(v[j].x, v[j].y); w.y = pk2(v[j].z, v[j].w); brow[64 * j] = w; }
            if (lane < 16) {
                const float inv_freq = exp2f(-(float)lane * (13.287712379549449f / 16.0f));
                const float ang = (float)positions[m] * inv_freq;
                cosb[m * 16 + lane] = cosf(ang); sinb[m * 16 + lane] = sinf(ang);
            }
        }
    } else {
        const float* xp = (const float*)(ws + WS_XPART);
        for (int m = (F.vcu * 512 + tid); m < T; m += F.G * 512) {
            const f32x4* p = (const f32x4*)(xp + (size_t)m * 16);
            const f32x4 a = p[0], b = p[1], c = p[2], d = p[3];
            const float s = ((a.x + a.y) + (a.z + a.w)) + ((b.x + b.y) + (b.z + b.w)) + ((c.x + c.y) + (c.z + c.w)) + ((d.x + d.y) + (d.z + d.w));
            rstd1[m] = rsqrtf(s * (1.f / DM) + EPS);
        }
    }
}

#define EPI_ARGS const f32x4 (&acc)[2][2][4][2], const GUnit& u, int wr, int wc, int fr_in, int fq_in
#define EPI_LAUNDER int fr = fr_in, fq = fq_in; asm volatile("" : "+v"(fr), "+v"(fq))
__device__ __forceinline__ float fq_sum(float s) { s += __shfl_xor(s, 16); s += __shfl_xor(s, 32); return s; }
__device__ __forceinline__ u32x4 pack8(const float (&v)[8]) { u32x4 w; w.x = pk2(v[0], v[1]); w.y = pk2(v[2], v[3]); w.z = pk2(v[4], v[5]); w.w = pk2(v[6], v[7]); return w; }
#define LOAD8(dst, ptr) do { const f32x4 a_ = *(const f32x4*)(ptr), b_ = *(const f32x4*)((ptr) + 4); dst[0] = a_.x; dst[1] = a_.y; dst[2] = a_.z; dst[3] = a_.w; dst[4] = b_.x; dst[5] = b_.y; dst[6] = b_.z; dst[7] = b_.w; } while (0)
#define ACC8(dst, ai, bj, m, sc) do { const f32x4 a_ = acc[ai][bj][m][0], b_ = acc[ai][bj][m][1]; dst[0] = a_.x * (sc); dst[1] = a_.y * (sc); dst[2] = a_.z * (sc); dst[3] = a_.w * (sc); dst[4] = b_.x * (sc); dst[5] = b_.y * (sc); dst[6] = b_.z * (sc); dst[7] = b_.w * (sc); } while (0)

__device__ __forceinline__ void rope8(float (&xn)[8], const float* cs, const float* sn, int fq) {
    float cv[8], sv[8]; LOAD8(cv, cs + 8 * (fq & 1)); LOAD8(sv, sn + 8 * (fq & 1));
#pragma unroll
    for (int i = 0; i < 8; ++i) { const float other = __shfl_xor(xn[i], 32); xn[i] = (fq < 2) ? (xn[i] * cv[i] - other * sv[i]) : (other * sv[i] + xn[i] * cv[i]); }
}

struct EpiP1 {
    unsigned char* ws; const float *gkc_rope, *b_forget;
    __device__ __forceinline__ void operator()(EPI_ARGS) const {
        EPI_LAUNDER;
        const int pn = u.pn, row0 = u.pm * 256 + wr * 64 + fr;
        const float* rstd1 = (const float*)(ws + WS_RSTD1);
        if (pn < 12) {
            const int bi = pn >> 1, half = pn & 1, ty = bi % 3;
            bf16_t* dst = (bf16_t*)(ws + WS_QA + (size_t)bi * 32 * MiB);
            const float* gain = (const float*)(ws + WS_GTAB) + ((bi >= 3 ? 2 : 0) + ty) * 64;
            float g0[8], g1[8];
            if (ty != 2) { LOAD8(g0, gain + 8 * fq); LOAD8(g1, gain + 32 + 8 * fq); }
#pragma unroll
            for (int ai = 0; ai < 2; ++ai)
#pragma unroll
                for (int m = 0; m < 4; ++m) {
                    const int row = row0 + ai * 128 + m * 16; const float rs = rstd1[row];
                    float v0[8], v1[8]; ACC8(v0, ai, 0, m, rs); ACC8(v1, ai, 1, m, rs);
                    if (ty != 2) {
                        float ss = 0.f;
#pragma unroll
                        for (int i = 0; i < 8; ++i) ss += v0[i] * v0[i] + v1[i] * v1[i];
                        ss = fq_sum(ss);
                        const float rh = rsqrtf(ss * (1.f / 64.f) + EPS);
#pragma unroll
                        for (int i = 0; i < 8; ++i) { v0[i] *= rh * g0[i]; v1[i] *= rh * g1[i]; }
                    }
                    bf16_t* p = dst + (size_t)row * 512 + (4 * half + wc) * 64 + 8 * fq;
                    *(u32x4*)p = pack8(v0); *(u32x4*)(p + 32) = pack8(v1);
                    asm volatile("" ::: "memory");
                }
        } else if (pn == 12) {
            bf16_t* dst = (bf16_t*)(ws + WS_HCQ); float* part = (float*)(ws + WS_CQP);
#pragma unroll
            for (int ai = 0; ai < 2; ++ai)
#pragma unroll
                for (int m = 0; m < 4; ++m) {
                    const int row = row0 + ai * 128 + m * 16; const float rs = rstd1[row];
                    float v0[8], v1[8]; ACC8(v0, ai, 0, m, rs); ACC8(v1, ai, 1, m, rs);
                    float ss = 0.f;
#pragma unroll
                    for (int i = 0; i < 8; ++i) ss += v0[i] * v0[i] + v1[i] * v1[i];
                    ss = fq_sum(ss);
                    if (fq == 0) part[row * 4 + wc] = ss;
                    bf16_t* p = dst + (size_t)row * 256 + wc * 64 + 8 * fq;
                    *(u32x4*)p = pack8(v0); *(u32x4*)(p + 32) = pack8(v1);
                    asm volatile("" ::: "memory");
                }
        } else {
            bf16_t* dst = (bf16_t*)(ws + WS_HCKV); float* part = (float*)(ws + WS_CKVP);
            const float* cosb = (const float*)(ws + WS_COS); const float* sinb = (const float*)(ws + WS_SIN);
            float gr[8]; LOAD8(gr, gkc_rope + 8 * fq);
            float bfv[8]; LOAD8(bfv, b_forget);
#pragma unroll
            for (int ai = 0; ai < 2; ++ai)
#pragma unroll
                for (int m = 0; m < 4; ++m) {
                    const int row = row0 + ai * 128 + m * 16; const float rs = rstd1[row];
                    float v0[8], v1[8]; ACC8(v0, ai, 0, m, rs); ACC8(v1, ai, 1, m, rs);
                    float ss = 0.f;
#pragma unroll
                    for (int i = 0; i < 8; ++i) ss += v0[i] * v0[i];
                    ss = fq_sum(ss);
                    if (fq == 0) part[row * 4 + wc] = ss;
                    *(u32x4*)(dst + (size_t)row * 128 + wc * 32 + 8 * fq) = pack8(v0);
                    if (wc == 0) {
                        float s2 = 0.f;
#pragma unroll
                        for (int i = 0; i < 8; ++i) s2 += v1[i] * v1[i];
                        s2 = fq_sum(s2);
                        const float rh = rsqrtf(s2 * (1.f / 32.f) + EPS);
#pragma unroll
                        for (int i = 0; i < 8; ++i) v1[i] *= rh * gr[i];
                        rope8(v1, cosb + (size_t)row * 16, sinb + (size_t)row * 16, fq);
                        *(u32x4*)((bf16_t*)(ws + WS_KROPE) + (size_t)row * 32 + 8 * fq) = pack8(v1);
                    } else if (wc == 1) {
                        if (fq == 0) {
                            float* lf = (float*)(ws + WS_LOGF) + (size_t)row * 8;
                            f32x4 a, b;
                            a.x = log_sigmoid_f(v1[0] + bfv[0]); a.y = log_sigmoid_f(v1[1] + bfv[1]); a.z = log_sigmoid_f(v1[2] + bfv[2]); a.w = log_sigmoid_f(v1[3] + bfv[3]);
                            b.x = log_sigmoid_f(v1[4] + bfv[4]); b.y = log_sigmoid_f(v1[5] + bfv[5]); b.z = log_sigmoid_f(v1[6] + bfv[6]); b.w = log_sigmoid_f(v1[7] + bfv[7]);
                            *(f32x4*)lf = a; *(f32x4*)(lf + 4) = b;
                        }
                    }
                    asm volatile("" ::: "memory");
                }
        }
    }
};
struct SchedP1 {
    unsigned char* ws; int G, c;
    __device__ __forceinline__ bool next(int i, GUnit& u) const {
        int pm, pn; if (!static_tile(i * G + c, 128, 14, pm, pn)) return false;
        u.A = (const char*)(ws + WS_XB) + (size_t)pm * 256 * 2048; u.B = (const char*)(ws + WS_WIN) + (size_t)pn * 256 * 2048;
        u.lda2 = 2048; u.ldb2 = 2048; u.nt = 16; u.pm = pm; u.pn = pn; u.kind = 0; u.flags = 0; u.rows = nullptr; u.nvalid = 0; u.aux0 = 0; u.aux1 = 0; u.aux2 = 0;
        return true;
    }
};

struct EpiP2 {
    unsigned char* ws; const float *gq_c, *gk_c;
    __device__ __forceinline__ void operator()(EPI_ARGS) const {
        EPI_LAUNDER;
        const int kind = u.kind, row0 = u.pm * 256 + wr * 64 + fr;
        const float* part = (const float*)(ws + (kind < 3 ? WS_CQP : WS_CKVP));
        const float invn = kind < 3 ? (1.f / 256.f) : (1.f / 128.f);
        const float* cosb = (const float*)(ws + WS_COS); const float* sinb = (const float*)(ws + WS_SIN);
        float g0[8], g1[8];
        if (kind == 2) { LOAD8(g0, gq_c + 64 + 8 * fq);
#pragma unroll
            for (int i = 0; i < 8; ++i) { g0[i] *= C2_96; g1[i] = g0[i]; } }
        else if (kind < 2) { LOAD8(g0, gq_c + 8 * fq); LOAD8(g1, gq_c + 32 + 8 * fq);
#pragma unroll
            for (int i = 0; i < 8; ++i) { g0[i] *= C2_96; g1[i] *= C2_96; } }
        else if (kind < 5) { LOAD8(g0, gk_c + 8 * fq); LOAD8(g1, gk_c + 32 + 8 * fq); }
#pragma unroll
        for (int ai = 0; ai < 2; ++ai)
#pragma unroll
            for (int m = 0; m < 4; ++m) {
                const int row = row0 + ai * 128 + m * 16;
                const f32x4 pp = *(const f32x4*)(part + (size_t)row * 4);
                const float rs = rsqrtf(((pp.x + pp.y) + (pp.z + pp.w)) * invn + EPS);
                float v0[8], v1[8]; ACC8(v0, ai, 0, m, rs); ACC8(v1, ai, 1, m, rs);
                if (kind == 2) {
                    float s0 = 0.f, s1 = 0.f;
#pragma unroll
                    for (int i = 0; i < 8; ++i) { s0 += v0[i] * v0[i]; s1 += v1[i] * v1[i]; }
                    s0 = fq_sum(s0); s1 = fq_sum(s1);
                    const float r0 = rsqrtf(s0 * (1.f / 32.f) + EPS), r1 = rsqrtf(s1 * (1.f / 32.f) + EPS);
#pragma unroll
                    for (int i = 0; i < 8; ++i) { v0[i] *= r0 * g0[i]; v1[i] *= r1 * g1[i]; }
                    rope8(v0, cosb + (size_t)row * 16, sinb + (size_t)row * 16, fq);
                    rope8(v1, cosb + (size_t)row * 16, sinb + (size_t)row * 16, fq);
                    bf16_t* p = (bf16_t*)(ws + WS_QROPE) + (size_t)row * 256 + 8 * fq;
                    *(u32x4*)(p + wc * 32) = pack8(v0); *(u32x4*)(p + (4 + wc) * 32) = pack8(v1);
                } else {
                    if (kind < 5) {
                        float ss = 0.f;
#pragma unroll
                        for (int i = 0; i < 8; ++i) ss += v0[i] * v0[i] + v1[i] * v1[i];
                        ss = fq_sum(ss);
                        const float rh = rsqrtf(ss * (1.f / 64.f) + EPS);
#pragma unroll
                        for (int i = 0; i < 8; ++i) { v0[i] *= rh * g0[i]; v1[i] *= rh * g1[i]; }
                    }
                    const int tt = kind < 2 ? kind : (kind < 5 ? kind - 3 : kind - 5);
                    bf16_t* base = (bf16_t*)(ws + (kind < 2 ? WS_QNOPE : (kind < 5 ? WS_KNOPE : WS_VC)));
                    bf16_t* p = base + (size_t)row * 512 + (4 * tt + wc) * 64 + 8 * fq;
                    *(u32x4*)p = pack8(v0); *(u32x4*)(p + 32) = pack8(v1);
                }
                asm volatile("" ::: "memory");
            }
    }
};
struct SchedP2 {
    unsigned char* ws; int G, c;
    __device__ __forceinline__ bool next(int i, GUnit& u) const {
        int L = i * G + c, pm, pn;
        u.flags = 0; u.rows = nullptr; u.nvalid = 0; u.aux0 = 0; u.aux1 = 0; u.aux2 = 0;
        if (L < 384) { static_tile(L, 128, 3, pm, pn);
            u.A = (const char*)(ws + WS_HCQ) + (size_t)pm * 256 * 512; u.B = (const char*)(ws + WS_WUQ) + (size_t)pn * 256 * 512; u.lda2 = 512; u.ldb2 = 512; u.nt = 4; u.pm = pm; u.pn = pn; u.kind = pn; return true; }
        L -= 384;
        if (!static_tile(L, 128, 4, pm, pn)) return false;
        u.A = (const char*)(ws + WS_HCKV) + (size_t)pm * 256 * 256; u.B = (const char*)(ws + WS_WUKV) + (size_t)pn * 256 * 256; u.lda2 = 256; u.ldb2 = 256; u.nt = 2; u.pm = pm; u.pn = pn; u.kind = 3 + pn; return true;
    }
};

struct EpiP4 {
    unsigned char* ws; int vcu;
    __device__ __forceinline__ void operator()(EPI_ARGS) const {
        EPI_LAUNDER;
        const int kind = u.kind, g = kind >> 1; int tid = threadIdx.x; asm volatile("" : "+v"(tid));
        const int row0 = u.pm * 256 + wr * 64 + fr;
        u32x4* GS = (u32x4*)(ws + WS_GSCR) + (size_t)vcu * (512 * 16) + tid;
        f32x4* MA = (f32x4*)(ws + WS_MACC) + (size_t)vcu * (512 * 32) + tid;
        if ((kind & 1) == 0) {
            const float* rstd1 = (const float*)(ws + WS_RSTD1);
#pragma unroll
            for (int ai = 0; ai < 2; ++ai)
#pragma unroll
                for (int m = 0; m < 4; ++m) {
                    const float rs = rstd1[row0 + ai * 128 + m * 16];
#pragma unroll
                    for (int bj = 0; bj < 2; ++bj) {
                        float v[8]; ACC8(v, ai, bj, m, rs);
#pragma unroll
                        for (int i = 0; i < 8; ++i) v[i] = sigmoid_f(v[i]);
                        GS[((ai * 4 + m) * 2 + bj) * 512] = pack8(v);
                    }
                    asm volatile("" ::: "memory");
                }
        } else {
            bf16_t* mb = (bf16_t*)(ws + WS_MBUF);
#pragma unroll
            for (int ai = 0; ai < 2; ++ai)
#pragma unroll
                for (int m = 0; m < 4; ++m) {
#pragma unroll
                    for (int bj = 0; bj < 2; ++bj) {
                        const int j = (ai * 4 + m) * 2 + bj;
                        const u32x4 gw = GS[j * 512];
                        f32x4 a = acc[ai][bj][m][0], b = acc[ai][bj][m][1];
                        a.x *= bflo(gw.x); a.y *= bfhi(gw.x); a.z *= bflo(gw.y); a.w *= bfhi(gw.y);
                        b.x *= bflo(gw.z); b.y *= bfhi(gw.z); b.z *= bflo(gw.w); b.w *= bfhi(gw.w);
                        if (g > 0) { a += MA[(j * 2 + 0) * 512]; b += MA[(j * 2 + 1) * 512]; }
                        if (g < 2) { MA[(j * 2 + 0) * 512] = a; MA[(j * 2 + 1) * 512] = b; }
                        else {
                            u32x4 w; w.x = pk2(a.x, a.y); w.y = pk2(a.z, a.w); w.z = pk2(b.x, b.y); w.w = pk2(b.z, b.w);
                            *(u32x4*)(mb + (size_t)(row0 + ai * 128 + m * 16) * 1024 + u.pn * 256 + bj * 128 + wc * 32 + 8 * fq) = w;
                        }
                    }
                    asm volatile("" ::: "memory");
                }
        }
    }
};
struct SchedP4 {
    unsigned char* ws; int G, c;
    __device__ __forceinline__ bool next(int i, GUnit& u) const {
        const int ti = i / 6, j = i - ti * 6, g = j >> 1; int pm, pn;
        if (!static_tile(ti * G + c, 128, 4, pm, pn)) return false;
        u.pm = pm; u.pn = pn; u.kind = j; u.flags = 0; u.rows = nullptr; u.nvalid = 0; u.aux0 = 0; u.aux1 = 0; u.aux2 = 0;
        if ((j & 1) == 0) { u.A = (const char*)(ws + WS_XB) + (size_t)pm * 256 * 2048; u.B = (const char*)(ws + WS_WIN) + (size_t)(14 + 4 * g + pn) * 256 * 2048; u.lda2 = 2048; u.ldb2 = 2048; u.nt = 16; }
        else { const size_t ob = g == 0 ? WS_OA : (g == 1 ? WS_QB : WS_QNOPE);
            u.A = (const char*)(ws + ob) + (size_t)pm * 256 * 1024; u.B = (const char*)(ws + WS_WBR) + ((size_t)g * 1024 + pn * 256) * 1024; u.lda2 = 1024; u.ldb2 = 1024; u.nt = 8; }
        return true;
    }
};

struct EpiP5 {
    unsigned char* ws; float* out;
    __device__ __forceinline__ void operator()(EPI_ARGS) const {
        EPI_LAUNDER;
        const int row0 = u.pm * 256 + wr * 64 + fr;
        bf16_t* xb = (bf16_t*)(ws + WS_XB);
#pragma unroll
        for (int ai = 0; ai < 2; ++ai)
#pragma unroll
            for (int m = 0; m < 4; ++m) {
#pragma unroll
                for (int bj = 0; bj < 2; ++bj) {
                    const size_t off = (size_t)(row0 + ai * 128 + m * 16) * 1024 + u.pn * 256 + bj * 128 + wc * 32 + 8 * fq;
                    f32x4 a = *(const f32x4*)(out + off), b = *(const f32x4*)(out + off + 4);
                    a += acc[ai][bj][m][0]; b += acc[ai][bj][m][1];
                    *(f32x4*)(out + off) = a; *(f32x4*)(out + off + 4) = b;
                    u32x4 w; w.x = pk2(a.x, a.y); w.y = pk2(a.z, a.w); w.z = pk2(b.x, b.y); w.w = pk2(b.z, b.w);
                    *(u32x4*)(xb + off) = w;
                }
                if (m & 1) asm volatile("" ::: "memory");
            }
    }
};
struct SchedP5 {
    unsigned char* ws; int G, c;
    __device__ __forceinline__ bool next(int i, GUnit& u) const {
        int pm, pn; if (!static_tile(i * G + c, 128, 4, pm, pn)) return false;
        u.A = (const char*)(ws + WS_MBUF) + (size_t)pm * 256 * 2048; u.B = (const char*)(ws + WS_WOUT) + (size_t)pn * 256 * 2048;
        u.lda2 = 2048; u.ldb2 = 2048; u.nt = 16; u.pm = pm; u.pn = pn; u.kind = 0; u.flags = 0; u.rows = nullptr; u.nvalid = 0; u.aux0 = 0; u.aux1 = 0; u.aux2 = 0;
        return true;
    }
};

__device__ __forceinline__ void phase_router(Ctx& F, int l) {
    LAS float* W = (LAS float*)F.lds;
    LAS int* misc = (LAS int*)(F.lds + MISC_OFF);
    const int tid = fresh_tid(), lane = tid & 63, wave = __builtin_amdgcn_readfirstlane(tid >> 6);
    const float* gn = argf(F, IN_NORM_FFN) + l * 1024; const float* wrg = argf(F, IN_W_RG) + (size_t)l * 1024 * 4; const float* wre = argf(F, IN_W_RE) + (size_t)l * 1024 * 16;
    for (int idx = tid; idx < 1024 * 20; idx += 512) { const int k = idx / 20, o = idx - k * 20; W[idx] = (o < 4 ? wrg[k * 4 + o] : wre[k * 16 + o - 4]) * gn[k]; }
    if (tid < 32) misc[MW_RCNT + tid] = 0;
    __syncthreads();
    const int tok0 = F.vcu * 128 + wave * 16;
    float lg[20]; float myss = 0.f;
#pragma unroll
    for (int o = 0; o < 20; ++o) lg[o] = 0.f;
#pragma unroll 1
    for (int pass = 0; pass < 4; ++pass) {
        const float* xr = F.out + (size_t)(tok0 + 4 * pass) * 1024 + lane;
        float a[4][20]; float ss[4];
#pragma unroll
        for (int t = 0; t < 4; ++t) { ss[t] = 0.f;
#pragma unroll
            for (int o = 0; o < 20; ++o) a[t][o] = 0.f; }
#pragma unroll 2
        for (int i = 0; i < 16; ++i) {
            const LAS f32x4* wp = (const LAS f32x4*)(W + (lane + 64 * i) * 20);
            const f32x4 w0 = wp[0], w1 = wp[1], w2 = wp[2], w3 = wp[3], w4 = wp[4];
            const float wv[20] = {w0.x, w0.y, w0.z, w0.w, w1.x, w1.y, w1.z, w1.w, w2.x, w2.y, w2.z, w2.w, w3.x, w3.y, w3.z, w3.w, w4.x, w4.y, w4.z, w4.w};
#pragma unroll
            for (int t = 0; t < 4; ++t) { const float xv = xr[(size_t)t * 1024 + 64 * i]; ss[t] += xv * xv;
#pragma unroll
                for (int o = 0; o < 20; ++o) a[t][o] += xv * wv[o]; }
        }
#pragma unroll
        for (int t = 0; t < 4; ++t) {
            const float sred = wave_sum(ss[t]); const bool mine = (lane == 4 * pass + t);
            if (mine) myss = sred;
#pragma unroll
            for (int o = 0; o < 20; ++o) { const float v = wave_sum(a[t][o]); if (mine) lg[o] = v; }
        }
    }
    int cls = 0, rank = 0; float w_lo = 0.f, w_hi = 0.f, rs = 0.f;
    const int tok = tok0 + lane;
    if (lane < 16) {
        rs = rsqrtf(myss * (1.f / 1024.f) + EPS);
        const float* brg = argf(F, IN_B_RG) + l * 4; const float* bre = argf(F, IN_B_RE) + l * 16;
        const float g0 = lg[0] * rs + brg[0], g1 = lg[1] * rs + brg[1], g2 = lg[2] * rs + brg[2], g3 = lg[3] * rs + brg[3];
        const float gm = fmaxf(fmaxf(g0, g1), fmaxf(g2, g3));
        const float p0 = expf(g0 - gm), p1 = expf(g1 - gm), p2 = expf(g2 - gm), p3 = expf(g3 - gm);
        const float ps = p0 + p1 + p2 + p3;
        int gi = 0; float pb = p0;
        if (p1 > pb) { pb = p1; gi = 1; }
        if (p2 > pb) { pb = p2; gi = 2; }
        if (p3 > pb) { pb = p3; gi = 3; }
        const float pg_top = pb / ps;
        float e0 = gi == 0 ? lg[4] : (gi == 1 ? lg[8] : (gi == 2 ? lg[12] : lg[16]));
        float e1 = gi == 0 ? lg[5] : (gi == 1 ? lg[9] : (gi == 2 ? lg[13] : lg[17]));
        float e2 = gi == 0 ? lg[6] : (gi == 1 ? lg[10] : (gi == 2 ? lg[14] : lg[18]));
        float e3 = gi == 0 ? lg[7] : (gi == 1 ? lg[11] : (gi == 2 ? lg[15] : lg[19]));
        e0 = e0 * rs + bre[gi * 4 + 0]; e1 = e1 * rs + bre[gi * 4 + 1]; e2 = e2 * rs + bre[gi * 4 + 2]; e3 = e3 * rs + bre[gi * 4 + 3];
        int i0 = 0; float b0 = e0;
        if (e1 > b0) { b0 = e1; i0 = 1; }
        if (e2 > b0) { b0 = e2; i0 = 2; }
        if (e3 > b0) { b0 = e3; i0 = 3; }
        int i1 = -1; float b1 = -INFINITY;
        if (i0 != 0 && e0 > b1) { b1 = e0; i1 = 0; }
        if (i0 != 1 && e1 > b1) { b1 = e1; i1 = 1; }
        if (i0 != 2 && e2 > b1) { b1 = e2; i1 = 2; }
        if (i0 != 3 && e3 > b1) { b1 = e3; i1 = 3; }
        const float ex1 = expf(b1 - b0);
        float one = 1.0f; asm volatile("" : "+v"(one));
        const float den2 = one + ex1;
        const float we0 = pg_top / den2, we1 = ex1 * pg_top / den2;
        const int lo = i0 < i1 ? i0 : i1, hi = i0 < i1 ? i1 : i0;
        w_lo = i0 < i1 ? we0 : we1; w_hi = i0 < i1 ? we1 : we0;
        const int pidx = lo == 0 ? hi - 1 : (lo == 1 ? hi + 1 : 5);
        cls = gi * 6 + pidx;
        rank = __hip_atomic_fetch_add((LAS int*)(misc + MW_RCNT + cls), 1, __ATOMIC_RELAXED, __HIP_MEMORY_SCOPE_WORKGROUP);
    }
    __syncthreads();
    if (tid < 24) { const int n = misc[MW_RCNT + tid];
        misc[MW_RBASE + tid] = n > 0 ? (int)__hip_atomic_fetch_add((unsigned*)(F.ws + WS_CTL) + CW_CNT + (l * 32 + tid) * 64, (unsigned)n, __ATOMIC_RELAXED, __HIP_MEMORY_SCOPE_AGENT) : 0; }
    __syncthreads();
    if (lane < 16) {
        const int pos = misc[MW_RBASE + cls] + rank;
        ((int*)(F.ws + WS_PERM))[(size_t)cls * T + pos] = tok;
        ((float*)(F.ws + WS_RW0))[tok] = w_lo; ((float*)(F.ws + WS_RW1))[tok] = w_hi; ((float*)(F.ws + WS_RSTD2))[tok] = rs;
    }
    __syncthreads();
}
__device__ __forceinline__ void moe_build_table(Ctx& F, int l) {
    LAS int* misc = (LAS int*)(F.lds + MISC_OFF);
    if (fresh_tid() == 0) {
        int s = 0;
        for (int c = 0; c < 24; ++c) { const int n = (int)__hip_atomic_load((unsigned*)(F.ws + WS_CTL) + CW_CNT + (l * 32 + c) * 64, __ATOMIC_RELAXED, __HIP_MEMORY_SCOPE_AGENT);
            misc[MW_TCNT + c] = n; misc[MW_TSTART + c] = s; s += (n + 255) >> 8; }
        misc[MW_TSTART + 24] = s;
    }
    __syncthreads();
}
__device__ __forceinline__ void moe_tile(const LAS int* misc, int tau, int& c, int& off, int& nvalid) {
    c = 0;
#pragma unroll 1
    for (int k = 1; k < 24; ++k) if (misc[MW_TSTART + k] <= tau) c = k;
#pragma unroll 1
    for (int k = 0; k < 24; ++k) if (misc[MW_TSTART + k] <= tau && tau < misc[MW_TSTART + k + 1]) c = k;
    off = (tau - misc[MW_TSTART + c]) * 256; nvalid = misc[MW_TCNT + c] - off; if (nvalid > 256) nvalid = 256;
}
__device__ __forceinline__ void cls_experts(int c, int& elo, int& ehi) {
    const int g = c / 6, p = c - g * 6;
    const int lo = p < 3 ? 0 : (p < 5 ? 1 : 2), hi = p < 3 ? p + 1 : (p < 5 ? p - 1 : 3);
    elo = 4 * g + lo; ehi = 4 * g + hi;
}
struct SchedMoeA {
    unsigned char* ws; const LAS int* misc; int G, c;
    __device__ __forceinline__ bool next(int i, GUnit& u) const {
        const int L = i * G + c, NT = misc[MW_TSTART + 24]; if (L >= NT * 4) return false;
        const int tau = L >> 2, pn = L & 3; int cl, off, nv; moe_tile(misc, tau, cl, off, nv);
        int elo, ehi; cls_experts(cl, elo, ehi); const int e = pn < 2 ? elo : ehi;
        u.A = (const char*)(ws + WS_XB); u.B = (const char*)(ws + WS_WGU) + ((size_t)e * 512 + (pn & 1) * 256) * 2048;
        u.lda2 = 2048; u.ldb2 = 2048; u.nt = 16; u.pm = tau; u.pn = pn; u.kind = 0; u.flags = 0;
        u.rows = (const int*)(ws + WS_PERM) + (size_t)cl * T + off; u.nvalid = nv; u.aux0 = cl; u.aux1 = 0; u.aux2 = 0;
        return true;
    }
};
struct EpiMoeA {
    unsigned char* ws;
    __device__ __forceinline__ void operator()(EPI_ARGS) const {
        EPI_LAUNDER;
        const int pn = u.pn, es = pn >> 1;
        const float* rw = (const float*)(ws + (es == 0 ? WS_RW0 : WS_RW1)); const float* rstd2 = (const float*)(ws + WS_RSTD2);
        bf16_t* hid = (bf16_t*)(ws + WS_HID);
#pragma unroll
        for (int ai = 0; ai < 2; ++ai)
#pragma unroll
            for (int m = 0; m < 4; ++m) {
                const int ridx = ai * 128 + wr * 64 + m * 16 + fr;
                if (ridx < u.nvalid) {
                    const int tok = u.rows[ridx]; const float r2 = rstd2[tok], w = rw[tok];
                    float gv[8], uv[8], h[8]; ACC8(gv, ai, 0, m, r2); ACC8(uv, ai, 1, m, r2);
#pragma unroll
                    for (int i = 0; i < 8; ++i) h[i] = gv[i] * sigmoid_f(gv[i]) * uv[i] * w;
                    *(u32x4*)(hid + ((size_t)u.pm * 256 + ridx) * 512 + es * 256 + (pn & 1) * 128 + wc * 32 + 8 * fq) = pack8(h);
                }
                if (m & 1) asm volatile("" ::: "memory");
            }
    }
};
struct SchedMoeB {
    unsigned char* ws; const LAS int* misc; int G, c;
    __device__ __forceinline__ bool next(int i, GUnit& u) const {
        const int j = i & 1, L = (i >> 1) * G + c, NT = misc[MW_TSTART + 24]; if (L >= NT * 4) return false;
        const int tau = L >> 2, pn = L & 3; int cl, off, nv; moe_tile(misc, tau, cl, off, nv);
        int elo, ehi; cls_experts(cl, elo, ehi); const int e = j == 0 ? elo : ehi;
        u.A = (const char*)(ws + WS_HID) + (size_t)tau * 256 * 1024 + j * 512; u.B = (const char*)(ws + WS_WD) + ((size_t)e * 1024 + pn * 256) * 512;
        u.lda2 = 1024; u.ldb2 = 512; u.nt = 4; u.pm = tau; u.pn = pn; u.kind = 0; u.flags = (j == 0) ? 1 : 0;
        u.rows = (const int*)(ws + WS_PERM) + (size_t)cl * T + off; u.nvalid = nv; u.aux0 = cl; u.aux1 = 0; u.aux2 = 0;
        return true;
    }
};
struct EpiMoeB {
    unsigned char* ws; float* out;
    __device__ __forceinline__ void operator()(EPI_ARGS) const {
        EPI_LAUNDER;
        bf16_t* xb = (bf16_t*)(ws + WS_XB); float* xpart = (float*)(ws + WS_XPART);
#pragma unroll
        for (int ai = 0; ai < 2; ++ai)
#pragma unroll
            for (int m = 0; m < 4; ++m) {
                const int ridx = ai * 128 + wr * 64 + m * 16 + fr; const bool ok = ridx < u.nvalid;
                const int tok = ok ? u.rows[ridx] : 0;
                float ss = 0.f;
#pragma unroll
                for (int bj = 0; bj < 2; ++bj) {
                    const size_t off = (size_t)tok * 1024 + u.pn * 256 + bj * 128 + wc * 32 + 8 * fq;
                    f32x4 a = *(const f32x4*)(out + off), b = *(const f32x4*)(out + off + 4);
                    a += acc[ai][bj][m][0]; b += acc[ai][bj][m][1];
                    ss += (a.x * a.x + a.y * a.y) + (a.z * a.z + a.w * a.w) + (b.x * b.x + b.y * b.y) + (b.z * b.z + b.w * b.w);
                    if (ok) {
                        *(f32x4*)(out + off) = a; *(f32x4*)(out + off + 4) = b;
                        u32x4 w; w.x = pk2(a.x, a.y); w.y = pk2(a.z, a.w); w.z = pk2(b.x, b.y); w.w = pk2(b.z, b.w);
                        *(u32x4*)(xb + off) = w;
                    }
                }
                ss = fq_sum(ss);
                if (ok && fq == 0) xpart[(size_t)tok * 16 + u.pn * 4 + wc] = ss;
                if (m & 1) asm volatile("" ::: "memory");
            }
    }
};

namespace att {
constexpr int GRP_LDS = 45056, OFF_K = 0, OFF_V = 24576, OFF_CK = 40960, OFF_TB = 41472;
#define ATT_WAITBAR() asm volatile("s_waitcnt vmcnt(0) lgkmcnt(0)\n\ts_barrier" ::: "memory")
#define ATT_BAR() asm volatile("s_waitcnt lgkmcnt(0)\n\ts_barrier" ::: "memory")
__device__ __forceinline__ s16x4 vtr(const LAS char* p) { return __builtin_bit_cast(s16x4, __builtin_amdgcn_ds_read_tr16_b64_v4i16((LAS s16x4*)p)); }

template <int TYPE>
__device__ __forceinline__ void attn_unit(unsigned char* ws, LAS unsigned char* lds, const float* rel_bias, int b, int hp, int br, int cls, int qb, int mergemode) {
    constexpr int DK = (TYPE == 2) ? 96 : 64, NDS = DK / 16, NKC = DK / 8;
    const int tid = fresh_tid(), lane = tid & 63, r32 = lane & 31, hi = lane >> 5;
    const int wave = __builtin_amdgcn_readfirstlane(tid >> 6), grp = wave >> 2, w4 = wave & 3;
    const int h = 2 * hp + grp;
    LAS unsigned char* gl = lds + grp * GRP_LDS;
    const int dil = (TYPE == 0) ? (br == 0 ? 1 : (br == 1 ? 4 : 16)) : 1;
    const int rowb = b * SEQ + ((TYPE == 0) ? cls : 0);
    const int Q0 = qb * 128, qlo = Q0 + 32 * w4, qpos = qlo + r32;
    const int t0 = (TYPE == 0) ? ((qb >= 1) ? 2 * qb - 2 : 0) : 0;
    const int nsteps = (TYPE == 0) ? ((qb >= 1) ? 4 : 2) : 2 * qb + 2;
    const size_t qbytes = (TYPE == 0) ? WS_QA : (TYPE == 1 ? WS_QB : WS_QNOPE);
    const size_t kbytes = (TYPE == 0) ? WS_KA : (TYPE == 1 ? WS_KB : WS_KNOPE);
    const size_t vbytes = (TYPE == 0) ? WS_VA : (TYPE == 1 ? WS_VB : WS_VC);
    const size_t obytes = (TYPE == 0) ? WS_OA : (TYPE == 1 ? WS_QB : WS_QNOPE);
    const char* Kg = (const char*)(ws + kbytes) + h * 128; const char* Vg = (const char*)(ws + vbytes) + h * 128;
    const char* Krp = (const char*)(ws + WS_KROPE);
    const float* cum = (const float*)(ws + WS_CUM);
    const size_t qrow = (size_t)(rowb + qpos * dil);
    bf16x8 qf[NDS];
    {
        const char* qp = (const char*)(ws + qbytes) + qrow * 1024 + h * 128 + hi * 16;
#pragma unroll
        for (int ds = 0; ds < 4; ++ds) qf[ds] = *(const bf16x8*)(qp + ds * 32);
        if (TYPE == 2) { const char* qr = (const char*)(ws + WS_QROPE) + qrow * 512 + h * 64 + hi * 16;
#pragma unroll
            for (int ds = 4; ds < NDS; ++ds) qf[ds] = *(const bf16x8*)(qr + (ds - 4) * 32); }
    }
    float cq2 = 0.f; if (TYPE == 1) cq2 = cum[qrow * 8 + h];
    if (TYPE == 0) {
        LAS float* TB = (LAS float*)(gl + OFF_TB); const int idx = w4 * 64 + lane, dist = idx - 63;
        TB[idx] = (dist >= 0 && dist <= 128) ? rel_bias[(int)T5B[br][dist] * 8 + h] * LOG2E : -INFINITY;
    }
#define ATT_ISSUE(tau, bufi) do { \
        const int k0_ = (tau) * 64; \
        { const size_t krow_ = (size_t)(rowb + (k0_ + lane) * dil); \
          _Pragma("unroll") for (int c_ = w4; c_ < NKC; c_ += 4) { \
              const char* src_ = (c_ < 8) ? (Kg + krow_ * 1024 + c_ * 16) : (Krp + krow_ * 64 + (c_ - 8) * 16); \
              __builtin_amdgcn_global_load_lds((const unsigned*)src_, (LAS unsigned*)(gl + OFF_K + (bufi) * 12288 + c_ * 1024), 16, 0, 0); } } \
        { _Pragma("unroll") for (int p_ = w4; p_ < 8; p_ += 4) { \
              const size_t vrow_ = (size_t)(rowb + (k0_ + 16 * (p_ & 3) + (lane >> 2)) * dil); \
              const char* src_ = Vg + vrow_ * 1024 + (p_ >> 2) * 64 + (lane & 3) * 16; \
              __builtin_amdgcn_global_load_lds((const unsigned*)src_, (LAS unsigned*)(gl + OFF_V + (bufi) * 8192 + p_ * 1024), 16, 0, 0); } } \
        if (TYPE == 1 && w4 == 0) { const size_t krow_ = (size_t)(rowb + (k0_ + lane) * dil); \
              __builtin_amdgcn_global_load_lds((const unsigned*)(cum + krow_ * 8 + h), (LAS unsigned*)(gl + OFF_CK + (bufi) * 256), 4, 0, 0); } \
    } while (0)
    float mrun = -1e30f, lrun = 0.f;
    f32x16 o0 = {}, o1 = {};
    ATT_ISSUE(t0, 0);
#pragma unroll 1
    for (int s = 0; s < nsteps; ++s) {
        const int tau = t0 + s, bufi = s & 1;
        ATT_WAITBAR();
        if (s + 1 < nsteps) ATT_ISSUE(tau + 1, bufi ^ 1);
        const int k0 = tau * 64;
        bool part = (k0 <= qlo + 31);
        if (TYPE == 0) part = part && (k0 + 63 >= qlo - 128);
        if (part) {
            const LAS char* Kb = (const LAS char*)(gl + OFF_K + bufi * 12288);
            const LAS char* Vb = (const LAS char*)(gl + OFF_V + bufi * 8192);
            f32x16 s0 = {}, s1 = {};
#pragma unroll
            for (int ds = 0; ds < NDS; ++ds) {
                const bf16x8 a0 = *(const LAS bf16x8*)(Kb + (2 * ds + hi) * 1024 + r32 * 16);
                const bf16x8 a1 = *(const LAS bf16x8*)(Kb + (2 * ds + hi) * 1024 + 512 + r32 * 16);
                s0 = __builtin_amdgcn_mfma_f32_32x32x16_bf16(a0, qf[ds], s0, 0, 0, 0);
                s1 = __builtin_amdgcn_mfma_f32_32x32x16_bf16(a1, qf[ds], s1, 0, 0, 0);
            }
            if (TYPE == 0) {
                const LAS float* TB = (const LAS float*)(gl + OFF_TB) + (qpos - k0 - 4 * hi + 63);
#pragma unroll
                for (int i = 0; i < 16; ++i) { const int cr = (i & 3) + 8 * (i >> 2); s0[i] += TB[-cr]; s1[i] += TB[-cr - 32]; }
            }
            if (TYPE == 1) {
                const LAS float* CK = (const LAS float*)(gl + OFF_CK + bufi * 256) + 4 * hi;
#pragma unroll
                for (int g4 = 0; g4 < 4; ++g4) {
                    const f32x4 c0 = *(const LAS f32x4*)(CK + 8 * g4), c1 = *(const LAS f32x4*)(CK + 32 + 8 * g4);
                    s0[4 * g4 + 0] += cq2 - c0.x; s0[4 * g4 + 1] += cq2 - c0.y; s0[4 * g4 + 2] += cq2 - c0.z; s0[4 * g4 + 3] += cq2 - c0.w;
                    s1[4 * g4 + 0] += cq2 - c1.x; s1[4 * g4 + 1] += cq2 - c1.y; s1[4 * g4 + 2] += cq2 - c1.z; s1[4 * g4 + 3] += cq2 - c1.w;
                }
            }
            if (TYPE != 0) {
                if (k0 + 63 > qlo) {
                    const int kb = k0 + 4 * hi;
#pragma unroll
                    for (int i = 0; i < 16; ++i) { const int kv = kb + (i & 3) + 8 * (i >> 2); if (kv > qpos) s0[i] = -INFINITY; if (kv + 32 > qpos) s1[i] = -INFINITY; }
                }
            }
            float mx = s0[0];
#pragma unroll
            for (int i = 1; i < 16; ++i) mx = fmaxf(mx, s0[i]);
#pragma unroll
            for (int i = 0; i < 16; ++i) mx = fmaxf(mx, s1[i]);
            mx = fmaxf(mx, __shfl_xor(mx, 32));
            const float mn = fmaxf(mrun, mx);
            const float alpha = fast_exp2(mrun - mn);
            mrun = mn;
            float rsum = 0.f;
#pragma unroll
            for (int i = 0; i < 16; ++i) { s0[i] = fast_exp2(s0[i] - mn); rsum += s0[i]; }
#pragma unroll
            for (int i = 0; i < 16; ++i) { s1[i] = fast_exp2(s1[i] - mn); rsum += s1[i]; }
            lrun = lrun * alpha + rsum;
#pragma unroll
            for (int i = 0; i < 16; ++i) { o0[i] *= alpha; o1[i] *= alpha; }
            u32x4 pw[4];
            pw[0] = (u32x4){pk2(s0[0], s0[1]), pk2(s0[2], s0[3]), pk2(s0[4], s0[5]), pk2(s0[6], s0[7])};
            pw[1] = (u32x4){pk2(s0[8], s0[9]), pk2(s0[10], s0[11]), pk2(s0[12], s0[13]), pk2(s0[14], s0[15])};
            pw[2] = (u32x4){pk2(s1[0], s1[1]), pk2(s1[2], s1[3]), pk2(s1[4], s1[5]), pk2(s1[6], s1[7])};
            pw[3] = (u32x4){pk2(s1[8], s1[9]), pk2(s1[10], s1[11]), pk2(s1[12], s1[13]), pk2(s1[14], s1[15])};
            const LAS char* vp = Vb + (4 * hi + ((lane & 15) >> 2)) * 64 + ((lane >> 4) & 1) * 32 + (lane & 3) * 8;
#pragma unroll
            for (int ks = 0; ks < 4; ++ks) {
                const s16x4 a_lo = vtr(vp + ks * 1024), a_hi = vtr(vp + ks * 1024 + 512);
                const s16x4 b_lo = vtr(vp + 4096 + ks * 1024), b_hi = vtr(vp + 4096 + ks * 1024 + 512);
                const bf16x8 va = (bf16x8){a_lo[0], a_lo[1], a_lo[2], a_lo[3], a_hi[0], a_hi[1], a_hi[2], a_hi[3]};
                const bf16x8 vb = (bf16x8){b_lo[0], b_lo[1], b_lo[2], b_lo[3], b_hi[0], b_hi[1], b_hi[2], b_hi[3]};
                const bf16x8 pf = __builtin_bit_cast(bf16x8, pw[ks]);
                o0 = __builtin_amdgcn_mfma_f32_32x32x16_bf16(va, pf, o0, 0, 0, 0);
                o1 = __builtin_amdgcn_mfma_f32_32x32x16_bf16(vb, pf, o1, 0, 0, 0);
            }
        }
    }
    const float ltot = lrun + __shfl_xor(lrun, 32);
    float ca = 0.f, cb = 1.f / ltot;
    float* lsep = (float*)(ws + WS_LSE) + qrow * 8 + h;
    char* op = (char*)(ws + obytes) + qrow * 1024 + h * 128 + hi * 8;
    if (TYPE == 0) {
        const float lc = mrun + fast_log2(ltot);
        if (mergemode == 0) { if (hi == 0) *lsep = lc; }
        else {
            const float lp = *lsep;
            const float M = fmaxf(lp, lc), wp = fast_exp2(lp - M), wn = fast_exp2(lc - M), den = wp + wn;
            ca = wp / den; cb = wn / (den * ltot);
            if (mergemode == 1 && hi == 0) *lsep = M + fast_log2(den);
        }
    }
#pragma unroll
    for (int gi = 0; gi < 4; ++gi) {
        float v0[4], v1[4];
#pragma unroll
        for (int e = 0; e < 4; ++e) { v0[e] = o0[4 * gi + e] * cb; v1[e] = o1[4 * gi + e] * cb; }
        if (TYPE == 0 && mergemode != 0) {
            const u32x2 p0 = *(const u32x2*)(op + gi * 16), p1 = *(const u32x2*)(op + 64 + gi * 16);
            v0[0] += ca * bflo(p0.x); v0[1] += ca * bfhi(p0.x); v0[2] += ca * bflo(p0.y); v0[3] += ca * bfhi(p0.y);
            v1[0] += ca * bflo(p1.x); v1[1] += ca * bfhi(p1.x); v1[2] += ca * bflo(p1.y); v1[3] += ca * bfhi(p1.y);
        }
        u32x2 w0, w1; w0.x = pk2(v0[0], v0[1]); w0.y = pk2(v0[2], v0[3]); w1.x = pk2(v1[0], v1[1]); w1.y = pk2(v1[2], v1[3]);
        *(u32x2*)(op + gi * 16) = w0; *(u32x2*)(op + 64 + gi * 16) = w1;
    }
    ATT_BAR();
#undef ATT_ISSUE
}
}

#ifndef PHMASK
#define PHMASK 0xffffffffu
#endif
#define PH(n) ((PHMASK >> (n)) & 1u)
#define FRESH_WS() do { asm volatile("" : "+s"(ws)); F.ws = ws; } while (0)
__device__ __forceinline__ void phase_scan(Ctx& F) {
    const int tid = fresh_tid(), lane = tid & 63, b = F.vcu, h = __builtin_amdgcn_readfirstlane(tid >> 6);
    const float* lf = (const float*)(F.ws + WS_LOGF) + (size_t)(b * SEQ + 32 * lane) * 8 + h;
    float* cm = (float*)(F.ws + WS_CUM) + (size_t)(b * SEQ + 32 * lane) * 8 + h;
    float v[32];
#pragma unroll
    for (int i = 0; i < 32; ++i) v[i] = lf[i * 8];
#pragma unroll
    for (int i = 1; i < 32; ++i) v[i] += v[i - 1];
    const float total = v[31]; float incl = total;
#pragma unroll
    for (int o = 1; o < 64; o <<= 1) { const float n = __shfl_up(incl, o); if (lane >= o) incl += n; }
    const float excl = incl - total;
#pragma unroll
    for (int i = 0; i < 32; ++i) cm[i * 8] = (excl + v[i]) * LOG2E;
}

__global__ void __launch_bounds__(512, 2) mega_fwd(Args args) {
    extern __shared__ __attribute__((aligned(16))) unsigned char lds_raw[];
    Ctx F;
    F.lds = (LAS unsigned char*)lds_raw; F.ws = args.ws; F.out = args.out;
    F.tid = threadIdx.x; F.lane = F.tid & 63; F.wave = __builtin_amdgcn_readfirstlane(F.tid >> 6);
    F.G = gridDim.x; { const int bx = blockIdx.x; F.vcu = (F.G % 8 == 0) ? (bx % 8) * (F.G / 8) + bx / 8 : bx; }
    unsigned char* ws = F.ws;
    LAS int* misc = (LAS int*)(F.lds + MISC_OFF);
    for (int i = F.tid; i < 1024; i += 512) misc[i] = 0;
    if (F.tid < 26) *(LAS unsigned long long*)(F.lds + ARGTAB_OFF + 8 * F.tid) = (unsigned long long)args.in[F.tid];
    __syncthreads();
    XcdBarrier bar = xcd_barrier_post((unsigned*)(ws + WS_CTL) + CW_BAR, (volatile LAS unsigned*)(misc + MW_BAR));
    const int bx = blockIdx.x, G = F.G, bhp = F.vcu >> 2, sub = F.vcu & 3, ab = bhp >> 2, ahp = bhp & 3;

#pragma unroll 1
    for (int l = 0; l < NLAYER; ++l) {
        FRESH_WS();
        if (PH(0)) phase_p0(F, l);
        xcd_barrier(bar);
        FRESH_WS();
        if (PH(1)) { SchedP1 S{ws, G, bx}; EpiP1 E{ws, argf(F, IN_GK_C) + l * 96 + 64, argf(F, IN_B_FORGET) + l * 8};
          g8::gemm_run<EpiP1, SchedP1, false>(F.lds, S, E); }
        xcd_barrier(bar);
        FRESH_WS();
        if (PH(2)) { SchedP2 S{ws, G, bx}; EpiP2 E{ws, argf(F, IN_GQ_C) + l * 96, argf(F, IN_GK_C) + l * 96};
          g8::gemm_run<EpiP2, SchedP2, false>(F.lds, S, E); }
        if (PH(3)) if (F.vcu < NBATCH) phase_scan(F);
#pragma unroll 1
        for (int k = 0; k < 4; ++k) if (PH(4)) att::attn_unit<0>(ws, F.lds, argf(F, IN_RELB), ab, ahp, 2, 4 * sub + k, 0, 0);
        xcd_barrier(bar);
        FRESH_WS();
#pragma unroll 1
        for (int k = 0; k < 4; ++k) if (PH(5)) att::attn_unit<0>(ws, F.lds, argf(F, IN_RELB), ab, ahp, 1, sub, k, 1);
#pragma unroll 1
        for (int k = 0; k < 4; ++k) { const int qb = (k == 0) ? sub : (k == 1 ? 7 - sub : (k == 2 ? 8 + sub : 15 - sub)); if (PH(6)) att::attn_unit<1>(ws, F.lds, argf(F, IN_RELB), ab, ahp, 0, 0, qb, 0); }
        xcd_barrier(bar);
        FRESH_WS();
#pragma unroll 1
        for (int k = 0; k < 4; ++k) if (PH(7)) att::attn_unit<0>(ws, F.lds, argf(F, IN_RELB), ab, ahp, 0, 0, 4 * sub + k, 2);
#pragma unroll 1
        for (int k = 0; k < 4; ++k) { const int qb = (k == 0) ? sub : (k == 1 ? 7 - sub : (k == 2 ? 8 + sub : 15 - sub)); if (PH(8)) att::attn_unit<2>(ws, F.lds, argf(F, IN_RELB), ab, ahp, 0, 0, qb, 0); }
        xcd_barrier(bar);
        FRESH_WS();
        if (PH(9)) { SchedP4 S{ws, G, bx}; EpiP4 E{ws, F.vcu};
          g8::gemm_run<EpiP4, SchedP4, false>(F.lds, S, E); }
        xcd_barrier(bar);
        FRESH_WS();
        if (PH(10)) { SchedP5 S{ws, G, bx}; EpiP5 E{ws, F.out};
          g8::gemm_run<EpiP5, SchedP5, false>(F.lds, S, E); }
        xcd_barrier(bar);
        FRESH_WS();
        if (PH(11)) phase_router(F, l);
        xcd_barrier(bar);
        FRESH_WS();
        moe_build_table(F, l);
        if (PH(12)) { SchedMoeA S{ws, (const LAS int*)misc, G, bx}; EpiMoeA E{ws};
          g8::gemm_run<EpiMoeA, SchedMoeA, true>(F.lds, S, E); }
        xcd_barrier(bar);
        FRESH_WS();
        if (PH(13)) { SchedMoeB S{ws, (const LAS int*)misc, G, bx}; EpiMoeB E{ws, F.out};
          g8::gemm_run<EpiMoeB, SchedMoeB, false>(F.lds, S, E); }
        xcd_barrier(bar);
    }
}

extern "C" void kernel_launch(void* const* d_in, const int* in_sizes, int n_in, void* d_out, int out_size, void* d_ws, size_t ws_size, hipStream_t stream) {
    static int ready = 0;
    if (ready == 0) {
        ready = 1;
        if (n_in != 26 || out_size != T * DM || ws_size < WS_END) { fprintf(stderr, "kernel_launch: unexpected problem (n_in %d, out %d, ws %zu)\n", n_in, out_size, ws_size); ready = -1; }
        else if (hipFuncSetAttribute((const void*)mega_fwd, hipFuncAttributeMaxDynamicSharedMemorySize, LDS_BYTES) != hipSuccess) { fprintf(stderr, "kernel_launch: hipFuncSetAttribute failed\n"); ready = -1; }
        (void)hipGetLastError();
    }
    if (ready < 0) return;
    (void)hipMemsetAsync((char*)d_ws + WS_CTL, 0, CTL_ZERO_BYTES, stream);
    Args a{};
    for (int i = 0; i < 26; ++i) a.in[i] = d_in[i];
    a.out = (float*)d_out; a.ws = (unsigned char*)d_ws;
    hipLaunchKernelGGL(mega_fwd, dim3(256), dim3(512), LDS_BYTES, stream, a);
}
```

```cpp
#include <hip/hip_runtime.h>
#include <cstdint>
#include <cstdio>

#define LAS __attribute__((address_space(3)))
#define GAS __attribute__((address_space(1)))
typedef unsigned short bf16_t;
typedef short bf16x8 __attribute__((ext_vector_type(8)));
typedef short s16x4 __attribute__((ext_vector_type(4)));
typedef float f32x2 __attribute__((ext_vector_type(2)));
typedef float f32x4 __attribute__((ext_vector_type(4)));
typedef float f32x16 __attribute__((ext_vector_type(16)));
typedef unsigned u32x2 __attribute__((ext_vector_type(2)));
typedef unsigned u32x4 __attribute__((ext_vector_type(4)));

constexpr int T = 32768, SEQ = 2048, NBATCH = 16, DM = 1024, NLAYER = 4, D_IN = 6568;
constexpr int OFF_A = 0, OFF_B = 1536, OFF_F = 3072, OFF_CQ = 3080, OFF_CKV = 3336, OFF_KR = 3464, OFF_G = 3496;
constexpr float LOG2E = 1.4426950408889634f;
constexpr float C2_64 = 0.125f * 1.4426950408889634f;
constexpr float C2_96 = 0.10206207261596577f * 1.4426950408889634f;
constexpr float EPS = 1e-6f;

__constant__ unsigned char T5B[3][129] = {
{0,1,2,3,4,5,6,7,8,9,10,11,12,13,14,15,16,16,16,16,16,16,17,17,17,17,17,17,17,17,18,18,18,18,18,18,18,18,18,18,19,19,19,19,19,19,19,19,19,19,19,19,19,19,20,20,20,20,20,20,20,20,20,20,20,20,20,20,20,20,20,20,20,21,21,21,21,21,21,21,21,21,21,21,21,21,21,21,21,21,21,21,21,21,21,21,21,21,21,22,22,22,22,22,22,22,22,22,22,22,22,22,22,22,22,22,22,22,22,22,22,22,22,22,22,22,22,22,22},
{0,4,8,12,16,16,17,17,18,18,19,19,19,19,20,20,20,20,20,21,21,21,21,21,21,22,22,22,22,22,22,22,22,22,23,23,23,23,23,23,23,23,23,23,23,23,24,24,24,24,24,24,24,24,24,24,24,24,24,24,24,24,25,25,25,25,25,25,25,25,25,25,25,25,25,25,25,25,25,25,25,25,25,26,26,26,26,26,26,26,26,26,26,26,26,26,26,26,26,26,26,26,26,26,26,26,26,26,26,26,26,26,26,27,27,27,27,27,27,27,27,27,27,27,27,27,27,27,27},
{0,16,18,19,20,21,21,22,22,23,23,23,24,24,24,24,25,25,25,25,25,26,26,26,26,26,26,26,26,27,27,27,27,27,27,27,27,27,27,28,28,28,28,28,28,28,28,28,28,28,28,28,29,29,29,29,29,29,29,29,29,29,29,29,29,29,29,29,29,29,30,30,30,30,30,30,30,30,30,30,30,30,30,30,30,30,30,30,30,30,30,30,30,30,30,31,31,31,31,31,31,31,31,31,31,31,31,31,31,31,31,31,31,31,31,31,31,31,31,31,31,31,31,31,31,31,31,31,31}};

constexpr size_t MiB = (size_t)1 << 20;
constexpr size_t WS_CTL = 0, CTL_ZERO_BYTES = 1 * MiB;
constexpr size_t WS_RSTD1 = 1 * MiB;
constexpr size_t WS_RSTD2 = 1 * MiB + 256 * 1024;
constexpr size_t WS_XPART = 2 * MiB;
constexpr size_t WS_CQP = 4 * MiB;
constexpr size_t WS_CKVP = 4 * MiB + 512 * 1024;
constexpr size_t WS_LOGF = 5 * MiB;
constexpr size_t WS_CUM = 6 * MiB;
constexpr size_t WS_LSE = 7 * MiB;
constexpr size_t WS_RCLS = 8 * MiB;
constexpr size_t WS_RW0 = 8 * MiB + 256 * 1024;
constexpr size_t WS_RW1 = 8 * MiB + 512 * 1024;
constexpr size_t WS_GTAB = 8 * MiB + 768 * 1024;
constexpr size_t WS_PERM = 9 * MiB;
constexpr size_t WS_KROPE = 12 * MiB;
constexpr size_t WS_COS = 14 * MiB;
constexpr size_t WS_SIN = 16 * MiB;
constexpr size_t WS_WIN = 18 * MiB;
constexpr size_t WS_WUQ = 31 * MiB;
constexpr size_t WS_WUKV = 31 * MiB + 512 * 1024;
constexpr size_t WS_WBR = 32 * MiB;
constexpr size_t WS_WOUT = 35 * MiB;
constexpr size_t WS_WGU = 37 * MiB;
constexpr size_t WS_WD = 53 * MiB;
constexpr size_t WS_XB = 64 * MiB;
constexpr size_t WS_QA = 128 * MiB, WS_KA = 160 * MiB, WS_VA = 192 * MiB, WS_QB = 224 * MiB, WS_KB = 256 * MiB, WS_VB = 288 * MiB;
constexpr size_t WS_HCQ = 320 * MiB;
constexpr size_t WS_HCKV = 336 * MiB;
constexpr size_t WS_QNOPE = 344 * MiB;
constexpr size_t WS_QROPE = 376 * MiB;
constexpr size_t WS_KNOPE = 392 * MiB;
constexpr size_t WS_VC = 424 * MiB;
constexpr size_t WS_OA = 456 * MiB;
constexpr size_t WS_END = 488 * MiB;
constexpr size_t WS_GSCR = WS_QA;
constexpr size_t WS_MACC = WS_KB;
constexpr size_t WS_MBUF = WS_KA;
constexpr size_t WS_HID = WS_VB;
constexpr int CW_BAR = 4096;
constexpr int CW_CNT = 16384;

constexpr int RING_BYTES = 131072;
constexpr int MISC_OFF = RING_BYTES;
constexpr int LDS_BYTES = 147456;

__device__ __forceinline__ unsigned f2bf(float f) { unsigned u = __builtin_bit_cast(unsigned, f); return (u + 0x7fffu + ((u >> 16) & 1u)) >> 16; }
__device__ __forceinline__ unsigned pk2(float lo, float hi) { typedef __bf16 bf16x2_t __attribute__((ext_vector_type(2))); f32x2 v = {lo, hi}; bf16x2_t b = __builtin_convertvector(v, bf16x2_t); return __builtin_bit_cast(unsigned, b); }
__device__ __forceinline__ float bf2f(unsigned short h) { return __builtin_bit_cast(float, (unsigned)h << 16); }
__device__ __forceinline__ float bflo(unsigned w) { return __builtin_bit_cast(float, w << 16); }
__device__ __forceinline__ float bfhi(unsigned w) { return __builtin_bit_cast(float, w & 0xffff0000u); }
__device__ __forceinline__ float wave_sum(float v) {
#pragma unroll
    for (int o = 1; o < 64; o <<= 1) v += __shfl_xor(v, o);
    return v;
}
__device__ __forceinline__ float fast_exp2(float x) { return __builtin_amdgcn_exp2f(x); }
__device__ __forceinline__ float fast_log2(float x) { return __builtin_amdgcn_logf(x); }
__device__ __forceinline__ float sigmoid_f(float x) { return __builtin_amdgcn_rcpf(1.0f + __builtin_amdgcn_exp2f(-1.4426950408889634f * x)); }
__device__ __forceinline__ float log_sigmoid_f(float x) { return fminf(x, 0.f) - log1pf(expf(-fabsf(x))); }
__device__ __forceinline__ int fresh_tid() { int t = threadIdx.x; asm volatile("" : "+v"(t)); return t; }
#define LDS_WAIT() asm volatile("s_waitcnt lgkmcnt(0)" ::: "memory")
#define VM_WAIT() asm volatile("s_waitcnt vmcnt(0)" ::: "memory")

#define XB_TMO      128
#define XB_XCNT(j)  (256  + 64 * (j))
#define XB_XSUB(j)  (1280 + 64 * (j))
#define XB_XGEN(j)  (2304 + 64 * (j))
#define XB_TOP      3328
#define XB_TOPGEN   3392
#define XCD_BAR_WORDS 3456
#define XB_SPIN_CAP (1u << 24)
__device__ __forceinline__ unsigned xb_ld(unsigned* p)              { return __hip_atomic_load(p, __ATOMIC_RELAXED, __HIP_MEMORY_SCOPE_AGENT); }
__device__ __forceinline__ unsigned xb_add(unsigned* p, unsigned v) { return __hip_atomic_fetch_add(p, v, __ATOMIC_RELAXED, __HIP_MEMORY_SCOPE_AGENT); }
__device__ __forceinline__ unsigned xb_xcc_id() { return (unsigned)__builtin_amdgcn_s_getreg((3 << 11) | 20) & 0xFu; }
#define XB_SPIN(cond, bar) do { unsigned _sp = 0; while (cond) { __builtin_amdgcn_s_sleep(1); \
    if ((++_sp & 255u) == 0u) { if (xb_ld(&(bar)[XB_TMO])) break; if (_sp > XB_SPIN_CAP) { atomicAdd(&(bar)[XB_TMO], 1u); break; } } } } while (0)
struct XcdBarrier { unsigned* bar; unsigned x; volatile LAS unsigned* st; };
__device__ __forceinline__ XcdBarrier xcd_barrier_post(unsigned* bar, volatile LAS unsigned* st) {
    XcdBarrier b; b.bar = bar; b.x = xb_xcc_id(); b.st = st;
    if (threadIdx.x == 0) (void)xb_add(&bar[XB_XCNT(b.x)], 1u);
    return b;
}
__device__ __forceinline__ void xcd_barrier_complete(unsigned* bar, unsigned x, unsigned& nloc, unsigned& nx) {
    const unsigned G = gridDim.x * gridDim.y * gridDim.z;
    unsigned sum, cnt, mine, sp = 0u;
    for (;;) {
        sum = 0u; cnt = 0u; mine = 0u;
#pragma unroll
        for (unsigned j = 0; j < 16; ++j) { const unsigned c = xb_ld(&bar[XB_XCNT(j)]); sum += c; cnt += (c > 0u) ? 1u : 0u; mine = (j == x) ? c : mine; }
        if (sum == G) break;
        __builtin_amdgcn_s_sleep(1);
        if ((++sp & 255u) == 0u) { if (xb_ld(&bar[XB_TMO])) break; if (sp > XB_SPIN_CAP) { atomicAdd(&bar[XB_TMO], 1u); break; } }
    }
    nloc = mine > 0u ? mine : 1u; nx = cnt > 0u ? cnt : 1u;
}
__device__ __forceinline__ void xcd_barrier(const XcdBarrier& b) {
    asm volatile("s_waitcnt vmcnt(0)" ::: "memory");
    __syncthreads();
    if (threadIdx.x == 0) {
        unsigned* bar = b.bar; unsigned bx_ = b.x;
        asm volatile("" : "+s"(bar), "+s"(bx_));
        __builtin_amdgcn_s_waitcnt(0);
        unsigned nloc = b.st[0], nx = b.st[1];
        if (nloc == 0u) { xcd_barrier_complete(bar, bx_, nloc, nx); b.st[0] = nloc; b.st[1] = nx; }
        const unsigned old = xb_add(&bar[XB_XSUB(bx_)], 1u);
        const unsigned gen = old / nloc;
        if (old + 1u == (gen + 1u) * nloc) {
            __builtin_amdgcn_fence(__ATOMIC_RELEASE, "agent");
            asm volatile("s_waitcnt vmcnt(0)" ::: "memory");
            const unsigned og = xb_add(&bar[XB_TOP], 1u);
            const unsigned tg = og / nx;
            if (og + 1u == (tg + 1u) * nx) xb_add(&bar[XB_TOPGEN], 1u);
            else XB_SPIN(xb_ld(&bar[XB_TOPGEN]) == tg, bar);
            __builtin_amdgcn_fence(__ATOMIC_ACQUIRE, "agent");
            xb_add(&bar[XB_XGEN(bx_)], 1u);
            asm volatile("s_waitcnt vmcnt(0)" ::: "memory");
        } else {
            XB_SPIN(xb_ld(&bar[XB_XGEN(bx_)]) == gen, bar);
            __builtin_amdgcn_fence(__ATOMIC_ACQUIRE, "agent");
            asm volatile("s_waitcnt vmcnt(0)" ::: "memory");
        }
    }
    __syncthreads();
}

namespace g8 {
constexpr int BM = 256, BK = 64, HALF = 128, HTB = HALF * BK * 2, STAGE_BYTES = 8 * HTB;
__device__ __forceinline__ int lds_byte(int r, int c) { const int st = (r >> 4) * 2 + (c >> 5), rr = r & 15, cc = c & 31, ob = rr * 64 + cc * 2; return st * 1024 + (ob ^ (((ob >> 9) & 1) << 5)); }
__device__ __forceinline__ void stage_rc(int b, int& R, int& C) { const int st = b / 1024, sb = b % 1024, swz = sb ^ (((sb >> 9) & 1) << 5); R = (st >> 1) * 16 + swz / 64; C = (st & 1) * 32 + (swz % 64) / 2; }
__device__ __forceinline__ int perm32(int rho) { const int n = rho >> 4, i = rho & 15; return 8 * (i >> 2) + 4 * n + (i & 3); }

struct GUnit {
    const char* A; const char* B;
    int lda2, ldb2;
    int nt;
    int pm, pn, kind, flags;
    const int* rows; int nvalid;
    int aux0, aux1, aux2;
};

template <class Epi, class Sched, bool GATHER>
__device__ __forceinline__ void gemm_run(LAS unsigned char* lds, const Sched& S, Epi& E) {
    const int tid = fresh_tid(), wid = __builtin_amdgcn_readfirstlane(tid >> 6), lane = tid & 63, wr = wid >> 2, wc = wid & 3, fr = lane & 15, fq = lane >> 4;
    int R0, C0, R1, C1; stage_rc(tid * 16, R0, C0); stage_rc(tid * 16 + 8192, R1, C1);
    const int Rb0 = (R0 & ~31) + perm32(R0 & 31), Rb1 = (R1 & ~31) + perm32(R1 & 31);
    unsigned C0x2 = (unsigned)C0 * 2u, C1x2 = (unsigned)C1 * 2u; asm volatile("" : "+v"(C0x2), "+v"(C1x2));
    const unsigned ldsw = (unsigned)wid * 1024u;
    const int aoff = lds_byte(wr * 64 + fr, fq * 8), boff = lds_byte(wc * 32 + fr, fq * 8);
#define G8_SA(b, h) (((b) * 2 + (h)) * HTB)
#define G8_SB(b, h) ((4 + (b) * 2 + (h)) * HTB)
#define G8_STAGE(bufoff, gbase, ld, ra, rb) do { \
        __builtin_amdgcn_global_load_lds((const unsigned*)((const char*)(gbase) + (__umul24((unsigned)(ra), (unsigned)(ld)) + C0x2)), (LAS unsigned*)(lds + (bufoff) + ldsw), 16, 0, 0); \
        __builtin_amdgcn_global_load_lds((const unsigned*)((const char*)(gbase) + (__umul24((unsigned)(rb), (unsigned)(ld)) + C1x2)), (LAS unsigned*)(lds + (bufoff) + ldsw + 8192), 16, 0, 0); } while (0)
#define G8_STAGE_G(bufoff, gbase, ga, gb) do { \
        __builtin_amdgcn_global_load_lds((const unsigned*)((const char*)(gbase) + (((unsigned)(ga) << 11) + C0x2)), (LAS unsigned*)(lds + (bufoff) + ldsw), 16, 0, 0); \
        __builtin_amdgcn_global_load_lds((const unsigned*)((const char*)(gbase) + (((unsigned)(gb) << 11) + C1x2)), (LAS unsigned*)(lds + (bufoff) + ldsw + 8192), 16, 0, 0); } while (0)
#define G8_STAGE_A(bufoff, pa, lda_, h, g0, g1) do { if (GATHER) G8_STAGE_G(bufoff, pa, g0, g1); else G8_STAGE(bufoff, (pa) + (size_t)(h) * 128 * (lda_), lda_, R0, R1); } while (0)
#define G8_STAGE_B(bufoff, pb, ldb_, h) G8_STAGE(bufoff, (pb) + (size_t)(h) * 128 * (ldb_), ldb_, Rb0, Rb1)
#define G8_LDA(dst, b, h) do { _Pragma("unroll") for (int m = 0; m < 4; ++m) _Pragma("unroll") for (int k = 0; k < 2; ++k) dst[m][k] = *(const LAS bf16x8*)(lds + G8_SA(b, h) + aoff + m * 2048 + k * 1024); } while (0)
#define G8_LDB(dst, b, h) do { _Pragma("unroll") for (int n = 0; n < 2; ++n) _Pragma("unroll") for (int k = 0; k < 2; ++k) dst[n][k] = *(const LAS bf16x8*)(lds + G8_SB(b, h) + boff + n * 2048 + k * 1024); } while (0)
#define G8_MMA(ai, bj, At, Bt) do { __builtin_amdgcn_s_setprio(1); _Pragma("unroll") for (int m = 0; m < 4; ++m) _Pragma("unroll") for (int n = 0; n < 2; ++n) _Pragma("unroll") for (int k = 0; k < 2; ++k) \
        acc[ai][bj][m][n] = __builtin_amdgcn_mfma_f32_16x16x32_bf16(Bt[n][k], At[m][k], acc[ai][bj][m][n], 0, 0, 0); __builtin_amdgcn_s_setprio(0); } while (0)
#define G8_WAIT_V(n) asm volatile("s_waitcnt vmcnt(" #n ")" ::: "memory")
#define G8_WAIT_L(n) asm volatile("s_waitcnt lgkmcnt(" #n ")" ::: "memory")
#define G8_BAR __builtin_amdgcn_s_barrier()
#define G8_SCHED __builtin_amdgcn_sched_barrier(0)
#define G8_ROWS(u, g00, g01, g10, g11) do { if (GATHER) { const int n_ = (u).nvalid; const int* rw_ = (u).rows; \
        g00 = (R0 < n_) ? rw_[R0] : 0; g01 = (R1 < n_) ? rw_[R1] : 0; g10 = (128 + R0 < n_) ? rw_[128 + R0] : 0; g11 = (128 + R1 < n_) ? rw_[128 + R1] : 0; } } while (0)
    GUnit cur, nxt; int ui = 0;
    if (!S.next(0, cur)) return;
    f32x4 acc[2][2][4][2];
#pragma unroll
    for (int a = 0; a < 2; ++a)
#pragma unroll
        for (int b = 0; b < 2; ++b)
#pragma unroll
            for (int m = 0; m < 4; ++m)
#pragma unroll
                for (int n = 0; n < 2; ++n) acc[a][b][m][n] = (f32x4){0.f, 0.f, 0.f, 0.f};
    bf16x8 At[4][2], B0[2][2], B1[2][2];
    int cg00 = 0, cg01 = 0, cg10 = 0, cg11 = 0, ng00 = 0, ng01 = 0, ng10 = 0, ng11 = 0;
    G8_ROWS(cur, cg00, cg01, cg10, cg11);
    const char* cA = cur.A; const char* cB = cur.B; int clda = cur.lda2, cldb = cur.ldb2;
    G8_STAGE_B(G8_SB(0, 0), cB, cldb, 0); G8_STAGE_B(G8_SB(0, 1), cB, cldb, 1); G8_STAGE_A(G8_SA(0, 0), cA, clda, 0, cg00, cg01); G8_STAGE_A(G8_SA(0, 1), cA, clda, 1, cg10, cg11);
    if (wr == 1) G8_BAR;
    G8_WAIT_V(2); G8_BAR;
    G8_STAGE_B(G8_SB(1, 0), cB + 128, cldb, 0); G8_STAGE_A(G8_SA(1, 0), cA + 128, clda, 0, cg00, cg01); G8_STAGE_B(G8_SB(1, 1), cB + 128, cldb, 1);
    G8_WAIT_V(6); G8_BAR;
    for (;;) {
        const bool has_next = S.next(ui + 1, nxt);
        const char* nA; const char* nB; int nlda, nldb;
        if (has_next) { nA = nxt.A; nB = nxt.B; nlda = nxt.lda2; nldb = nxt.ldb2; G8_ROWS(nxt, ng00, ng01, ng10, ng11); }
        else { nA = cA; nB = cB; nlda = clda; nldb = cldb; ng00 = cg00; ng01 = cg01; ng10 = cg10; ng11 = cg11; }
        const int nt = cur.nt;
        for (int t = 0; t < nt; t += 2) {
            const bool last = (t == nt - 2);
            asm volatile("" : "+v"(C0x2), "+v"(C1x2));
            const char* a1 = cA + (size_t)(t + 1) * 128;
            const char* a2 = last ? nA : cA + (size_t)(t + 2) * 128; const char* b2 = last ? nB : cB + (size_t)(t + 2) * 128;
            const char* a3 = a2 + 128; const char* b3 = b2 + 128;
            const int slda = last ? nlda : clda, sldb = last ? nldb : cldb;
            const int sg00 = last ? ng00 : cg00, sg01 = last ? ng01 : cg01, sg10 = last ? ng10 : cg10, sg11 = last ? ng11 : cg11;
            G8_LDB(B0, 0, 0); G8_LDB(B1, 0, 1); G8_SCHED; G8_LDA(At, 0, 0); G8_STAGE_A(G8_SA(1, 1), a1, clda, 1, cg10, cg11);
            G8_WAIT_V(8); G8_WAIT_L(0); G8_BAR; G8_MMA(0, 0, At, B0); G8_MMA(0, 1, At, B1); G8_BAR; G8_SCHED;
            G8_LDA(At, 0, 1); G8_STAGE_B(G8_SB(0, 0), b2, sldb, 0); G8_STAGE_B(G8_SB(0, 1), b2, sldb, 1); G8_STAGE_A(G8_SA(0, 0), a2, slda, 0, sg00, sg01);
            G8_WAIT_V(8); G8_WAIT_L(0); G8_BAR; G8_MMA(1, 0, At, B0); G8_MMA(1, 1, At, B1); G8_BAR; G8_SCHED;
            G8_LDB(B0, 1, 0); G8_LDB(B1, 1, 1); G8_SCHED; G8_LDA(At, 1, 0); G8_STAGE_A(G8_SA(0, 1), a2, slda, 1, sg10, sg11);
            G8_WAIT_V(8); G8_WAIT_L(0); G8_BAR; G8_MMA(0, 0, At, B0); G8_MMA(0, 1, At, B1); G8_BAR; G8_SCHED;
            G8_LDA(At, 1, 1); G8_STAGE_B(G8_SB(1, 0), b3, sldb, 0); G8_STAGE_B(G8_SB(1, 1), b3, sldb, 1); G8_STAGE_A(G8_SA(1, 0), a3, slda, 0, sg00, sg01);
            G8_WAIT_V(8); G8_WAIT_L(0); G8_BAR; G8_MMA(1, 0, At, B0); G8_MMA(1, 1, At, B1); G8_BAR; G8_SCHED;
        }
        if (wr == 0) G8_BAR;
        const bool noepi = (cur.flags & 1) != 0;
        if (!noepi) E(acc, cur, wr, wc, fr, fq);
        if (!has_next) break;
        if (!noepi) {
#pragma unroll
            for (int a = 0; a < 2; ++a)
#pragma unroll
                for (int b = 0; b < 2; ++b)
#pragma unroll
                    for (int m = 0; m < 4; ++m)
#pragma unroll
                        for (int n = 0; n < 2; ++n) acc[a][b][m][n] = (f32x4){0.f, 0.f, 0.f, 0.f};
        }
        cur = nxt; cA = nA; cB = nB; clda = nlda; cldb = nldb; ++ui;
        cg00 = ng00; cg01 = ng01; cg10 = ng10; cg11 = ng11;
        if (wr == 1) G8_BAR;
    }
    G8_WAIT_V(0);
    G8_BAR;
#undef G8_SA
#undef G8_SB
#undef G8_STAGE
#undef G8_STAGE_G
#undef G8_STAGE_A
#undef G8_STAGE_B
#undef G8_LDA
#undef G8_LDB
#undef G8_MMA
#undef G8_WAIT_V
#undef G8_WAIT_L
#undef G8_BAR
#undef G8_SCHED
#undef G8_ROWS
}
}
using g8::GUnit;

__device__ __forceinline__ bool static_tile(int L, int nM, int nN, int& pm, int& pn) {
    const int nwg = nM * nN; if (L >= nwg) return false;
    int wgid = L; { const int q = nwg / 8, r = nwg % 8, xcd = wgid % 8, off = wgid / 8; wgid = (xcd < r ? xcd * (q + 1) : r * (q + 1) + (xcd - r) * q) + off; }
    const int nig = 8 * nN, gid = wgid / nig, fm = gid * 8, gsz = (nM - fm) < 8 ? (nM - fm) : 8;
    pm = fm + ((wgid % nig) % gsz); pn = (wgid % nig) / gsz; return true;
}

struct Args { const void* in[26]; float* out; unsigned char* ws; };
struct Ctx {
    LAS unsigned char* lds; unsigned char* ws; float* out;
    int tid, lane, wave, vcu, G;
};
enum { IN_X = 0, IN_POS, IN_RELB, IN_NORM_MIX, IN_W_IN, IN_B_FORGET, IN_GQ_A, IN_GK_A, IN_GQ_B, IN_GK_B, IN_GQ_C, IN_GK_C, IN_NORM_CQ, IN_NORM_CKV, IN_W_UQ, IN_W_UKV, IN_W_BRANCH, IN_W_OUT, IN_NORM_FFN, IN_W_RG, IN_B_RG, IN_W_RE, IN_B_RE, IN_W_EG, IN_W_EU, IN_W_ED };
constexpr int ARGTAB_OFF = MISC_OFF + 2048;
__device__ __forceinline__ const float* argf(const Ctx& F, int k) {
    const unsigned long long v = *(const LAS unsigned long long*)(F.lds + ARGTAB_OFF + 8 * k);
    const unsigned lo = __builtin_amdgcn_readfirstlane((unsigned)v), hi = __builtin_amdgcn_readfirstlane((unsigned)(v >> 32));
    return (const float*)(((unsigned long long)hi << 32) | lo);
}
constexpr int MW_BAR = 8, MW_TCNT = 64, MW_TSTART = 96, MW_RCNT = 128, MW_RBASE = 160;

__device__ __forceinline__ void cvt_item(const float* src, int ld, int col0, int nvalid, const float* kscale, bf16_t* dst, int K, int n0, int k0, LAS float* scr, int lane) {
    const int n = lane & 31;
#pragma unroll 8
    for (int i = 0; i < 32; ++i) {
        const int kk = 2 * i + (lane >> 5);
        float v = 0.f;
        if (n < nvalid) { v = src[(size_t)(k0 + kk) * ld + col0 + n]; if (kscale) v *= kscale[k0 + kk]; }
        scr[kk * 33 + n] = v;
    }
    LDS_WAIT(); asm volatile("" ::: "memory");
    const int c = lane & 7;
#pragma unroll
    for (int j = 0; j < 4; ++j) {
        const int nn = (lane >> 3) + 8 * j; const LAS float* s = scr + (8 * c) * 33 + nn;
        u32x4 o; o.x = pk2(s[0 * 33], s[1 * 33]); o.y = pk2(s[2 * 33], s[3 * 33]); o.z = pk2(s[4 * 33], s[5 * 33]); o.w = pk2(s[6 * 33], s[7 * 33]);
        *(u32x4*)(dst + (size_t)(n0 + nn) * K + k0 + 8 * c) = o;
    }
    LDS_WAIT(); asm volatile("" ::: "memory");
}

__device__ __forceinline__ void phase_p0(Ctx& F, int l) {
    const int tid = fresh_tid(), lane = tid & 63, wave = __builtin_amdgcn_readfirstlane(tid >> 6);
    LAS float* scr = (LAS float*)(F.lds + wave * 8448);
    const int gw = F.vcu * 8 + wave, NGW = F.G * 8;
    unsigned char* ws = F.ws;
    constexpr int I_WIN = 208 * 16, I_UQ = 24 * 4, I_UKV = 32 * 2, I_BR = 3 * 32 * 8, I_OUT = 32 * 16, I_GU = 16 * 16 * 16, I_D = 16 * 32 * 4;
    constexpr int NITEMS = I_WIN + I_UQ + I_UKV + I_BR + I_OUT + I_GU + I_D;
    for (int it = gw; it < NITEMS; it += NGW) {
        int r = it;
        if (r < I_WIN) {
            const int nb = r >> 4, kb = r & 15, pn = nb >> 3, j = nb & 7, bj = j >> 2, wc = j & 3;
            int col0, nvalid = 32;
            if (pn < 12) { const int bi = pn >> 1, half = pn & 1; col0 = (bi < 3 ? OFF_A + bi * 512 : OFF_B + (bi - 3) * 512) + half * 256 + 64 * wc + 32 * bj; }
            else if (pn == 12) col0 = OFF_CQ + 64 * wc + 32 * bj;
            else if (pn == 13) { if (j < 4) col0 = OFF_CKV + 32 * j; else if (j == 4) col0 = OFF_KR; else if (j == 5) { col0 = OFF_F; nvalid = 8; } else { col0 = 0; nvalid = 0; } }
            else col0 = OFF_G + (pn - 14) * 256 + 32 * j;
            cvt_item(argf(F, IN_W_IN) + (size_t)l * 1024 * D_IN, D_IN, col0, nvalid, argf(F, IN_NORM_MIX) + l * 1024, (bf16_t*)(ws + WS_WIN), 1024, nb * 32, kb * 64, scr, lane);
            continue;
        }
        r -= I_WIN;
        if (r < I_UQ) {
            const int nb = r >> 2, kb = r & 3, tt = nb >> 3, j = nb & 7, bj = j >> 2, wc = j & 3;
            const int col0 = tt < 2 ? (4 * tt + wc) * 96 + 32 * bj : (4 * bj + wc) * 96 + 64;
            cvt_item(argf(F, IN_W_UQ) + (size_t)l * 256 * 768, 768, col0, 32, argf(F, IN_NORM_CQ) + l * 256, (bf16_t*)(ws + WS_WUQ), 256, nb * 32, kb * 64, scr, lane);
            continue;
        }
        r -= I_UQ;
        if (r < I_UKV) {
            const int nb = r >> 1, kb = r & 1, tt = nb >> 3, j = nb & 7, bj = j >> 2, wc = j & 3;
            const int col0 = tt < 2 ? (4 * tt + wc) * 128 + 32 * bj : (4 * (tt - 2) + wc) * 128 + 64 + 32 * bj;
            cvt_item(argf(F, IN_W_UKV) + (size_t)l * 128 * 1024, 1024, col0, 32, argf(F, IN_NORM_CKV) + l * 128, (bf16_t*)(ws + WS_WUKV), 128, nb * 32, kb * 64, scr, lane);
            continue;
        }
        r -= I_UKV;
        if (r < I_BR) {
            const int g = r >> 8, rr = r & 255, nb = rr >> 3, kb = rr & 7;
            cvt_item(argf(F, IN_W_BRANCH) + ((size_t)l * 3 + g) * 512 * 1024, 1024, nb * 32, 32, nullptr, (bf16_t*)(ws + WS_WBR) + (size_t)g * 1024 * 512, 512, nb * 32, kb * 64, scr, lane);
            continue;
        }
        r -= I_BR;
        if (r < I_OUT) {
            const int nb = r >> 4, kb = r & 15;
            cvt_item(argf(F, IN_W_OUT) + (size_t)l * 1024 * 1024, 1024, nb * 32, 32, nullptr, (bf16_t*)(ws + WS_WOUT), 1024, nb * 32, kb * 64, scr, lane);
            continue;
        }
        r -= I_OUT;
        if (r < I_GU) {
            const int e = r >> 8, rr = r & 255, nb = rr >> 4, kb = rr & 15, tt = nb >> 3, j = nb & 7, bj = j >> 2;
            const float* src = argf(F, bj == 0 ? IN_W_EG : IN_W_EU) + ((size_t)l * 16 + e) * 1024 * 256;
            cvt_item(src, 256, tt * 128 + 32 * (j & 3), 32, argf(F, IN_NORM_FFN) + l * 1024, (bf16_t*)(ws + WS_WGU) + (size_t)e * 512 * 1024, 1024, nb * 32, kb * 64, scr, lane);
            continue;
        }
        r -= I_GU;
        {
            const int e = r >> 7, rr = r & 127, nb = rr >> 2, kb = rr & 3;
            cvt_item(argf(F, IN_W_ED) + ((size_t)l * 16 + e) * 256 * 1024, 1024, nb * 32, 32, nullptr, (bf16_t*)(ws + WS_WD) + (size_t)e * 1024 * 256, 256, nb * 32, kb * 64, scr, lane);
        }
    }
    if (F.vcu == 0 && tid < 64) { float* gt = (float*)(ws + WS_GTAB); const int d = tid;
        gt[d] = argf(F, IN_GQ_A)[l * 64 + d] * C2_64; gt[64 + d] = argf(F, IN_GK_A)[l * 64 + d]; gt[128 + d] = argf(F, IN_GQ_B)[l * 64 + d] * C2_64; gt[192 + d] = argf(F, IN_GK_B)[l * 64 + d]; }
    float* rstd1 = (float*)(ws + WS_RSTD1);
    if (l == 0) {
        float* cosb = (float*)(ws + WS_COS); float* sinb = (float*)(ws + WS_SIN);
        const float* x_in = argf(F, IN_X); const int* positions = (const int*)argf(F, IN_POS);
        for (int m = gw; m < T; m += NGW) {
            const f32x4* xr = (const f32x4*)(x_in + (size_t)m * DM) + lane;
            f32x4 v[4]; float s = 0.f;
#pragma unroll
            for (int j = 0; j < 4; ++j) { v[j] = xr[64 * j]; s += (v[j].x * v[j].x + v[j].y * v[j].y) + (v[j].z * v[j].z + v[j].w * v[j].w); }
            s = wave_sum(s);
            if (lane == 0) rstd1[m] = rsqrtf(s * (1.f / DM) + EPS);
            f32x4* orow = (f32x4*)(F.out + (size_t)m * DM) + lane;
            u32x2* brow = (u32x2*)((bf16_t*)(ws + WS_XB) + (size_t)m * DM) + lane;
#pragma unroll
            for (int j = 0; j < 4; ++j) { orow[64 * j] = v[j]; u32x2 w; w.x = pk2(v[j].x, v[j].y); w.y = pk2(v[j].z, v[j].w); brow[64 * j] = w; }
            if (lane < 16) {
                const float inv_freq = exp2f(-(float)lane * (13.287712379549449f / 16.0f));
                const float ang = (float)positions[m] * inv_freq;
                cosb[m * 16 + lane] = cosf(ang); sinb[m * 16 + lane] = sinf(ang);
            }
        }
    } else {
        const float* xp = (const float*)(ws + WS_XPART);
        for (int m = (F.vcu * 512 + tid); m < T; m += F.G * 512) {
            const f32x4* p = (const f32x4*)(xp + (size_t)m * 16);
            const f32x4 a = p[0], b = p[1], c = p[2], d = p[3];
            const float s = ((a.x + a.y) + (a.z + a.w)) + ((b.x + b.y) + (b.z + b.w)) + ((c.x + c.y) + (c.z + c.w)) + ((d.x + d.y) + (d.z + d.w));
            rstd1[m] = rsqrtf(s * (1.f / DM) + EPS);
        }
    }
}

#define EPI_ARGS const f32x4 (&acc)[2][2][4][2], const GUnit& u, int wr, int wc, int fr_in, int fq_in
#define EPI_LAUNDER int fr = fr_in, fq = fq_in; asm volatile("" : "+v"(fr), "+v"(fq))
__device__ __forceinline__ float fq_sum(float s) { s += __shfl_xor(s, 16); s += __shfl_xor(s, 32); return s; }
__device__ __forceinline__ u32x4 pack8(const float (&v)[8]) { u32x4 w; w.x = pk2(v[0], v[1]); w.y = pk2(v[2], v[3]); w.z = pk2(v[4], v[5]); w.w = pk2(v[6], v[7]); return w; }
#define LOAD8(dst, ptr) do { const f32x4 a_ = *(const f32x4*)(ptr), b_ = *(const f32x4*)((ptr) + 4); dst[0] = a_.x; dst[1] = a_.y; dst[2] = a_.z; dst[3] = a_.w; dst[4] = b_.x; dst[5] = b_.y; dst[6] = b_.z; dst[7] = b_.w; } while (0)
#define ACC8(dst, ai, bj, m, sc) do { const f32x4 a_ = acc[ai][bj][m][0], b_ = acc[ai][bj][m][1]; dst[0] = a_.x * (sc); dst[1] = a_.y * (sc); dst[2] = a_.z * (sc); dst[3] = a_.w * (sc); dst[4] = b_.x * (sc); dst[5] = b_.y * (sc); dst[6] = b_.z * (sc); dst[7] = b_.w * (sc); } while (0)

#define ROWVALS8(dst, ptr, r0) do { _Pragma("unroll") for (int j_ = 0; j_ < 8; ++j_) dst[j_] = (ptr)[(r0) + (j_ >> 2) * 128 + (j_ & 3) * 16]; } while (0)
__device__ __forceinline__ void rope8(float (&xn)[8], const float* cs, const float* sn, int fq) {
    float cv[8], sv[8]; LOAD8(cv, cs + 8 * (fq & 1)); LOAD8(sv, sn + 8 * (fq & 1));
#pragma unroll
    for (int i = 0; i < 8; ++i) { const float other = __shfl_xor(xn[i], 32); xn[i] = (fq < 2) ? (xn[i] * cv[i] - other * sv[i]) : (other * sv[i] + xn[i] * cv[i]); }
}

struct EpiP1 {
    unsigned char* ws; const float *gkc_rope, *b_forget;
    __device__ __forceinline__ void operator()(EPI_ARGS) const {
        EPI_LAUNDER;
        const int pn = u.pn, row0 = u.pm * 256 + wr * 64 + fr;
        const float* rstd1 = (const float*)(ws + WS_RSTD1);
        float rsv[8]; ROWVALS8(rsv, rstd1, row0);
        if (pn < 12) {
            const int bi = pn >> 1, half = pn & 1, ty = bi % 3;
            bf16_t* dst = (bf16_t*)(ws + WS_QA + (size_t)bi * 32 * MiB);
            const float* gain = (const float*)(ws + WS_GTAB) + ((bi >= 3 ? 2 : 0) + ty) * 64;
            float g0[8], g1[8];
            if (ty != 2) { LOAD8(g0, gain + 8 * fq); LOAD8(g1, gain + 32 + 8 * fq); }
#pragma unroll
            for (int ai = 0; ai < 2; ++ai)
#pragma unroll
                for (int m = 0; m < 4; ++m) {
                    const int row = row0 + ai * 128 + m * 16; const float rs = rsv[ai * 4 + m];
                    float v0[8], v1[8]; ACC8(v0, ai, 0, m, rs); ACC8(v1, ai, 1, m, rs);
                    if (ty != 2) {
                        float ss = 0.f;
#pragma unroll
                        for (int i = 0; i < 8; ++i) ss += v0[i] * v0[i] + v1[i] * v1[i];
                        ss = fq_sum(ss);
                        const float rh = rsqrtf(ss * (1.f / 64.f) + EPS);
#pragma unroll
                        for (int i = 0; i < 8; ++i) { v0[i] *= rh * g0[i]; v1[i] *= rh * g1[i]; }
                    }
                    bf16_t* p = dst + (size_t)row * 512 + (4 * half + wc) * 64 + 8 * fq;
                    *(u32x4*)p = pack8(v0); *(u32x4*)(p + 32) = pack8(v1);
                    asm volatile("" ::: "memory");
                }
        } else if (pn == 12) {
            bf16_t* dst = (bf16_t*)(ws + WS_HCQ); float* part = (float*)(ws + WS_CQP);
#pragma unroll
            for (int ai = 0; ai < 2; ++ai)
#pragma unroll
                for (int m = 0; m < 4; ++m) {
                    const int row = row0 + ai * 128 + m * 16; const float rs = rsv[ai * 4 + m];
                    float v0[8], v1[8]; ACC8(v0, ai, 0, m, rs); ACC8(v1, ai, 1, m, rs);
                    float ss = 0.f;
#pragma unroll
                    for (int i = 0; i < 8; ++i) ss += v0[i] * v0[i] + v1[i] * v1[i];
                    ss = fq_sum(ss);
                    if (fq == 0) part[row * 4 + wc] = ss;
                    bf16_t* p = dst + (size_t)row * 256 + wc * 64 + 8 * fq;
                    *(u32x4*)p = pack8(v0); *(u32x4*)(p + 32) = pack8(v1);
                    asm volatile("" ::: "memory");
                }
        } else {
            bf16_t* dst = (bf16_t*)(ws + WS_HCKV); float* part = (float*)(ws + WS_CKVP);
            const float* cosb = (const float*)(ws + WS_COS); const float* sinb = (const float*)(ws + WS_SIN);
            float gr[8]; LOAD8(gr, gkc_rope + 8 * fq);
            float bfv[8]; LOAD8(bfv, b_forget);
#pragma unroll
            for (int ai = 0; ai < 2; ++ai)
#pragma unroll
                for (int m = 0; m < 4; ++m) {
                    const int row = row0 + ai * 128 + m * 16; const float rs = rsv[ai * 4 + m];
                    float v0[8], v1[8]; ACC8(v0, ai, 0, m, rs); ACC8(v1, ai, 1, m, rs);
                    float ss = 0.f;
#pragma unroll
                    for (int i = 0; i < 8; ++i) ss += v0[i] * v0[i];
                    ss = fq_sum(ss);
                    if (fq == 0) part[row * 4 + wc] = ss;
                    *(u32x4*)(dst + (size_t)row * 128 + wc * 32 + 8 * fq) = pack8(v0);
                    if (wc == 0) {
                        float s2 = 0.f;
#pragma unroll
                        for (int i = 0; i < 8; ++i) s2 += v1[i] * v1[i];
                        s2 = fq_sum(s2);
                        const float rh = rsqrtf(s2 * (1.f / 32.f) + EPS);
#pragma unroll
                        for (int i = 0; i < 8; ++i) v1[i] *= rh * gr[i];
                        rope8(v1, cosb + (size_t)row * 16, sinb + (size_t)row * 16, fq);
                        *(u32x4*)((bf16_t*)(ws + WS_KROPE) + (size_t)row * 32 + 8 * fq) = pack8(v1);
                    } else if (wc == 1) {
                        if (fq == 0) {
                            float* lf = (float*)(ws + WS_LOGF) + (size_t)row * 8;
                            f32x4 a, b;
                            a.x = log_sigmoid_f(v1[0] + bfv[0]); a.y = log_sigmoid_f(v1[1] + bfv[1]); a.z = log_sigmoid_f(v1[2] + bfv[2]); a.w = log_sigmoid_f(v1[3] + bfv[3]);
                            b.x = log_sigmoid_f(v1[4] + bfv[4]); b.y = log_sigmoid_f(v1[5] + bfv[5]); b.z = log_sigmoid_f(v1[6] + bfv[6]); b.w = log_sigmoid_f(v1[7] + bfv[7]);
                            *(f32x4*)lf = a; *(f32x4*)(lf + 4) = b;
                        }
                    }
                    asm volatile("" ::: "memory");
                }
        }
    }
};
struct SchedP1 {
    unsigned char* ws; int G, c;
    __device__ __forceinline__ bool next(int i, GUnit& u) const {
        int pm, pn; if (!static_tile(i * G + c, 128, 14, pm, pn)) return false;
        u.A = (const char*)(ws + WS_XB) + (size_t)pm * 256 * 2048; u.B = (const char*)(ws + WS_WIN) + (size_t)pn * 256 * 2048;
        u.lda2 = 2048; u.ldb2 = 2048; u.nt = 16; u.pm = pm; u.pn = pn; u.kind = 0; u.flags = 0; u.rows = nullptr; u.nvalid = 0; u.aux0 = 0; u.aux1 = 0; u.aux2 = 0;
        return true;
    }
};

struct EpiP2 {
    unsigned char* ws; const float *gq_c, *gk_c;
    __device__ __forceinline__ void operator()(EPI_ARGS) const {
        EPI_LAUNDER;
        const int kind = u.kind, row0 = u.pm * 256 + wr * 64 + fr;
        const float* part = (const float*)(ws + (kind < 3 ? WS_CQP : WS_CKVP));
        const float invn = kind < 3 ? (1.f / 256.f) : (1.f / 128.f);
        const float* cosb = (const float*)(ws + WS_COS); const float* sinb = (const float*)(ws + WS_SIN);
        float g0[8], g1[8];
        if (kind == 2) { LOAD8(g0, gq_c + 64 + 8 * fq);
#pragma unroll
            for (int i = 0; i < 8; ++i) { g0[i] *= C2_96; g1[i] = g0[i]; } }
        else if (kind < 2) { LOAD8(g0, gq_c + 8 * fq); LOAD8(g1, gq_c + 32 + 8 * fq);
#pragma unroll
            for (int i = 0; i < 8; ++i) { g0[i] *= C2_96; g1[i] *= C2_96; } }
        else if (kind < 5) { LOAD8(g0, gk_c + 8 * fq); LOAD8(g1, gk_c + 32 + 8 * fq); }
        float rsv[8];
        { f32x4 pv[8];
#pragma unroll
          for (int j = 0; j < 8; ++j) pv[j] = *(const f32x4*)(part + (size_t)(row0 + (j >> 2) * 128 + (j & 3) * 16) * 4);
#pragma unroll
          for (int j = 0; j < 8; ++j) rsv[j] = rsqrtf(((pv[j].x + pv[j].y) + (pv[j].z + pv[j].w)) * invn + EPS); }
#pragma unroll
        for (int ai = 0; ai < 2; ++ai)
#pragma unroll
            for (int m = 0; m < 4; ++m) {
                const int row = row0 + ai * 128 + m * 16;
                const float rs = rsv[ai * 4 + m];
                float v0[8], v1[8]; ACC8(v0, ai, 0, m, rs); ACC8(v1, ai, 1, m, rs);
                if (kind == 2) {
                    float s0 = 0.f, s1 = 0.f;
#pragma unroll
                    for (int i = 0; i < 8; ++i) { s0 += v0[i] * v0[i]; s1 += v1[i] * v1[i]; }
                    s0 = fq_sum(s0); s1 = fq_sum(s1);
                    const float r0 = rsqrtf(s0 * (1.f / 32.f) + EPS), r1 = rsqrtf(s1 * (1.f / 32.f) + EPS);
#pragma unroll
                    for (int i = 0; i < 8; ++i) { v0[i] *= r0 * g0[i]; v1[i] *= r1 * g1[i]; }
                    rope8(v0, cosb + (size_t)row * 16, sinb + (size_t)row * 16, fq);
                    rope8(v1, cosb + (size_t)row * 16, sinb + (size_t)row * 16, fq);
                    bf16_t* p = (bf16_t*)(ws + WS_QROPE) + (size_t)row * 256 + 8 * fq;
                    *(u32x4*)(p + wc * 32) = pack8(v0); *(u32x4*)(p + (4 + wc) * 32) = pack8(v1);
                } else {
                    if (kind < 5) {
                        float ss = 0.f;
#pragma unroll
                        for (int i = 0; i < 8; ++i) ss += v0[i] * v0[i] + v1[i] * v1[i];
                        ss = fq_sum(ss);
                        const float rh = rsqrtf(ss * (1.f / 64.f) + EPS);
#pragma unroll
                        for (int i = 0; i < 8; ++i) { v0[i] *= rh * g0[i]; v1[i] *= rh * g1[i]; }
                    }
                    const int tt = kind < 2 ? kind : (kind < 5 ? kind - 3 : kind - 5);
                    bf16_t* base = (bf16_t*)(ws + (kind < 2 ? WS_QNOPE : (kind < 5 ? WS_KNOPE : WS_VC)));
                    bf16_t* p = base + (size_t)row * 512 + (4 * tt + wc) * 64 + 8 * fq;
                    *(u32x4*)p = pack8(v0); *(u32x4*)(p + 32) = pack8(v1);
                }
                asm volatile("" ::: "memory");
            }
    }
};
struct SchedP2 {
    unsigned char* ws; int G, c;
    __device__ __forceinline__ bool next(int i, GUnit& u) const {
        int L = i * G + c, pm, pn;
        u.flags = 0; u.rows = nullptr; u.nvalid = 0; u.aux0 = 0; u.aux1 = 0; u.aux2 = 0;
        if (L < 384) { static_tile(L, 128, 3, pm, pn);
            u.A = (const char*)(ws + WS_HCQ) + (size_t)pm * 256 * 512; u.B = (const char*)(ws + WS_WUQ) + (size_t)pn * 256 * 512; u.lda2 = 512; u.ldb2 = 512; u.nt = 4; u.pm = pm; u.pn = pn; u.kind = pn; return true; }
        L -= 384;
        if (!static_tile(L, 128, 4, pm, pn)) return false;
        u.A = (const char*)(ws + WS_HCKV) + (size_t)pm * 256 * 256; u.B = (const char*)(ws + WS_WUKV) + (size_t)pn * 256 * 256; u.lda2 = 256; u.ldb2 = 256; u.nt = 2; u.pm = pm; u.pn = pn; u.kind = 3 + pn; return true;
    }
};

struct EpiP4 {
    unsigned char* ws; int vcu;
    __device__ __forceinline__ void operator()(EPI_ARGS) const {
        EPI_LAUNDER;
        const int kind = u.kind, g = kind >> 1; int tid = threadIdx.x; asm volatile("" : "+v"(tid));
        const int row0 = u.pm * 256 + wr * 64 + fr;
        u32x4* GS = (u32x4*)(ws + WS_GSCR) + (size_t)vcu * (512 * 16) + tid;
        u32x4* MS = (u32x4*)(ws + WS_MACC) + (size_t)vcu * (512 * 16) + tid;
        if ((kind & 1) == 0) {
            const float* rstd1 = (const float*)(ws + WS_RSTD1);
            float rsv[8]; ROWVALS8(rsv, rstd1, row0);
#pragma unroll
            for (int ai = 0; ai < 2; ++ai)
#pragma unroll
                for (int m = 0; m < 4; ++m) {
                    const float rs = rsv[ai * 4 + m];
#pragma unroll
                    for (int bj = 0; bj < 2; ++bj) {
                        float v[8]; ACC8(v, ai, bj, m, rs);
#pragma unroll
                        for (int i = 0; i < 8; ++i) v[i] = sigmoid_f(v[i]);
                        GS[((ai * 4 + m) * 2 + bj) * 512] = pack8(v);
                    }
                }
        } else {
            bf16_t* mb = (bf16_t*)(ws + WS_MBUF);
#pragma unroll
            for (int ai = 0; ai < 2; ++ai) {
                u32x4 gw[8], mw[8];
#pragma unroll
                for (int j = 0; j < 8; ++j) gw[j] = GS[(ai * 8 + j) * 512];
                if (g > 0) {
#pragma unroll
                    for (int j = 0; j < 8; ++j) mw[j] = MS[(ai * 8 + j) * 512];
                }
#pragma unroll
                for (int m = 0; m < 4; ++m)
#pragma unroll
                    for (int bj = 0; bj < 2; ++bj) {
                        const int j = m * 2 + bj;
                        f32x4 a = acc[ai][bj][m][0], b = acc[ai][bj][m][1];
                        a.x *= bflo(gw[j].x); a.y *= bfhi(gw[j].x); a.z *= bflo(gw[j].y); a.w *= bfhi(gw[j].y);
                        b.x *= bflo(gw[j].z); b.y *= bfhi(gw[j].z); b.z *= bflo(gw[j].w); b.w *= bfhi(gw[j].w);
                        if (g > 0) { a.x += bflo(mw[j].x); a.y += bfhi(mw[j].x); a.z += bflo(mw[j].y); a.w += bfhi(mw[j].y);
                                     b.x += bflo(mw[j].z); b.y += bfhi(mw[j].z); b.z += bflo(mw[j].w); b.w += bfhi(mw[j].w); }
                        u32x4 w; w.x = pk2(a.x, a.y); w.y = pk2(a.z, a.w); w.z = pk2(b.x, b.y); w.w = pk2(b.z, b.w);
                        if (g < 2) MS[(ai * 8 + j) * 512] = w;
                        else *(u32x4*)(mb + (size_t)(row0 + ai * 128 + m * 16) * 1024 + u.pn * 256 + bj * 128 + wc * 32 + 8 * fq) = w;
                    }
                asm volatile("" ::: "memory");
            }
        }
    }
};
struct SchedP4 {
    unsigned char* ws; int G, c;
    __device__ __forceinline__ bool next(int i, GUnit& u) const {
        const int ti = i / 6, j = i - ti * 6, g = j >> 1; int pm, pn;
        if (!static_tile(ti * G + c, 128, 4, pm, pn)) return false;
        u.pm = pm; u.pn = pn; u.kind = j; u.flags = 0; u.rows = nullptr; u.nvalid = 0; u.aux0 = 0; u.aux1 = 0; u.aux2 = 0;
        if ((j & 1) == 0) { u.A = (const char*)(ws + WS_XB) + (size_t)pm * 256 * 2048; u.B = (const char*)(ws + WS_WIN) + (size_t)(14 + 4 * g + pn) * 256 * 2048; u.lda2 = 2048; u.ldb2 = 2048; u.nt = 16; }
        else { const size_t ob = g == 0 ? WS_OA : (g == 1 ? WS_QB : WS_QNOPE);
            u.A = (const char*)(ws + ob) + (size_t)pm * 256 * 1024; u.B = (const char*)(ws + WS_WBR) + ((size_t)g * 1024 + pn * 256) * 1024; u.lda2 = 1024; u.ldb2 = 1024; u.nt = 8; }
        return true;
    }
};

struct EpiP5 {
    unsigned char* ws; float* out; bool dry;
    __device__ __forceinline__ void operator()(EPI_ARGS) const {
        EPI_LAUNDER;
        const int row0 = u.pm * 256 + wr * 64 + fr;
        bf16_t* xb = (bf16_t*)(ws + WS_XB);
#pragma unroll
        for (int ai = 0; ai < 2; ++ai) {
            f32x4 xa[8], xc[8];
#pragma unroll
            for (int j = 0; j < 8; ++j) { const size_t off = (size_t)(row0 + ai * 128 + (j >> 1) * 16) * 1024 + u.pn * 256 + (j & 1) * 128 + wc * 32 + 8 * fq;
                xa[j] = *(const f32x4*)(out + off); xc[j] = *(const f32x4*)(out + off + 4); }
#pragma unroll
            for (int j = 0; j < 8; ++j) { const int m = j >> 1, bj = j & 1;
                const size_t off = (size_t)(row0 + ai * 128 + m * 16) * 1024 + u.pn * 256 + bj * 128 + wc * 32 + 8 * fq;
                const f32x4 a = xa[j] + acc[ai][bj][m][0], b = xc[j] + acc[ai][bj][m][1];
                u32x4 w; w.x = pk2(a.x, a.y); w.y = pk2(a.z, a.w); w.z = pk2(b.x, b.y); w.w = pk2(b.z, b.w);
                if (!dry) { *(f32x4*)(out + off) = a; *(f32x4*)(out + off + 4) = b; *(u32x4*)(xb + off) = w; } }
            asm volatile("" ::: "memory");
        }
    }
};
struct SchedP5 {
    unsigned char* ws; int G, c;
    __device__ __forceinline__ bool next(int i, GUnit& u) const {
        int pm, pn; if (!static_tile(i * G + c, 128, 4, pm, pn)) return false;
        u.A = (const char*)(ws + WS_MBUF) + (size_t)pm * 256 * 2048; u.B = (const char*)(ws + WS_WOUT) + (size_t)pn * 256 * 2048;
        u.lda2 = 2048; u.ldb2 = 2048; u.nt = 16; u.pm = pm; u.pn = pn; u.kind = 0; u.flags = 0; u.rows = nullptr; u.nvalid = 0; u.aux0 = 0; u.aux1 = 0; u.aux2 = 0;
        return true;
    }
};

__device__ __forceinline__ void phase_router(Ctx& F, int l, bool dry) {
    LAS float* W = (LAS float*)F.lds;
    LAS int* misc = (LAS int*)(F.lds + MISC_OFF);
    const int tid = fresh_tid(), lane = tid & 63, wave = __builtin_amdgcn_readfirstlane(tid >> 6);
    const float* gn = argf(F, IN_NORM_FFN) + l * 1024; const float* wrg = argf(F, IN_W_RG) + (size_t)l * 1024 * 4; const float* wre = argf(F, IN_W_RE) + (size_t)l * 1024 * 16;
    for (int idx = tid; idx < 1024 * 20; idx += 512) { const int k = idx / 20, o = idx - k * 20; W[idx] = (o < 4 ? wrg[k * 4 + o] : wre[k * 16 + o - 4]) * gn[k]; }
    if (tid < 32) misc[MW_RCNT + tid] = 0;
    __syncthreads();
    const int tok0 = F.vcu * 128 + wave * 16;
    float lg[20]; float myss = 0.f;
#pragma unroll
    for (int o = 0; o < 20; ++o) lg[o] = 0.f;
#pragma unroll 1
    for (int pass = 0; pass < 4; ++pass) {
        const float* xr = F.out + (size_t)(tok0 + 4 * pass) * 1024 + lane;
        float a[4][20]; float ss[4];
#pragma unroll
        for (int t = 0; t < 4; ++t) { ss[t] = 0.f;
#pragma unroll
            for (int o = 0; o < 20; ++o) a[t][o] = 0.f; }
#pragma unroll 2
        for (int i = 0; i < 16; ++i) {
            const LAS f32x4* wp = (const LAS f32x4*)(W + (lane + 64 * i) * 20);
            const f32x4 w0 = wp[0], w1 = wp[1], w2 = wp[2], w3 = wp[3], w4 = wp[4];
            const float wv[20] = {w0.x, w0.y, w0.z, w0.w, w1.x, w1.y, w1.z, w1.w, w2.x, w2.y, w2.z, w2.w, w3.x, w3.y, w3.z, w3.w, w4.x, w4.y, w4.z, w4.w};
#pragma unroll
            for (int t = 0; t < 4; ++t) { const float xv = xr[(size_t)t * 1024 + 64 * i]; ss[t] += xv * xv;
#pragma unroll
                for (int o = 0; o < 20; ++o) a[t][o] += xv * wv[o]; }
        }
#pragma unroll
        for (int t = 0; t < 4; ++t) {
            const float sred = wave_sum(ss[t]); const bool mine = (lane == 4 * pass + t);
            if (mine) myss = sred;
#pragma unroll
            for (int o = 0; o < 20; ++o) { const float v = wave_sum(a[t][o]); if (mine) lg[o] = v; }
        }
    }
    int cls = 0, rank = 0; float w_lo = 0.f, w_hi = 0.f, rs = 0.f;
    const int tok = tok0 + lane;
    if (lane < 16) {
        rs = rsqrtf(myss * (1.f / 1024.f) + EPS);
        const float* brg = argf(F, IN_B_RG) + l * 4; const float* bre = argf(F, IN_B_RE) + l * 16;
        const float g0 = lg[0] * rs + brg[0], g1 = lg[1] * rs + brg[1], g2 = lg[2] * rs + brg[2], g3 = lg[3] * rs + brg[3];
        const float gm = fmaxf(fmaxf(g0, g1), fmaxf(g2, g3));
        const float p0 = expf(g0 - gm), p1 = expf(g1 - gm), p2 = expf(g2 - gm), p3 = expf(g3 - gm);
        const float ps = p0 + p1 + p2 + p3;
        int gi = 0; float pb = p0;
        if (p1 > pb) { pb = p1; gi = 1; }
        if (p2 > pb) { pb = p2; gi = 2; }
        if (p3 > pb) { pb = p3; gi = 3; }
        const float pg_top = pb / ps;
        float e0 = gi == 0 ? lg[4] : (gi == 1 ? lg[8] : (gi == 2 ? lg[12] : lg[16]));
        float e1 = gi == 0 ? lg[5] : (gi == 1 ? lg[9] : (gi == 2 ? lg[13] : lg[17]));
        float e2 = gi == 0 ? lg[6] : (gi == 1 ? lg[10] : (gi == 2 ? lg[14] : lg[18]));
        float e3 = gi == 0 ? lg[7] : (gi == 1 ? lg[11] : (gi == 2 ? lg[15] : lg[19]));
        e0 = e0 * rs + bre[gi * 4 + 0]; e1 = e1 * rs + bre[gi * 4 + 1]; e2 = e2 * rs + bre[gi * 4 + 2]; e3 = e3 * rs + bre[gi * 4 + 3];
        int i0 = 0; float b0 = e0;
        if (e1 > b0) { b0 = e1; i0 = 1; }
        if (e2 > b0) { b0 = e2; i0 = 2; }
        if (e3 > b0) { b0 = e3; i0 = 3; }
        int i1 = -1; float b1 = -INFINITY;
        if (i0 != 0 && e0 > b1) { b1 = e0; i1 = 0; }
        if (i0 != 1 && e1 > b1) { b1 = e1; i1 = 1; }
        if (i0 != 2 && e2 > b1) { b1 = e2; i1 = 2; }
        if (i0 != 3 && e3 > b1) { b1 = e3; i1 = 3; }
        const float ex1 = expf(b1 - b0);
        float one = 1.0f; asm volatile("" : "+v"(one));
        const float den2 = one + ex1;
        const float we0 = pg_top / den2, we1 = ex1 * pg_top / den2;
        const int lo = i0 < i1 ? i0 : i1, hi = i0 < i1 ? i1 : i0;
        w_lo = i0 < i1 ? we0 : we1; w_hi = i0 < i1 ? we1 : we0;
        const int pidx = lo == 0 ? hi - 1 : (lo == 1 ? hi + 1 : 5);
        cls = gi * 6 + pidx;
        rank = __hip_atomic_fetch_add((LAS int*)(misc + MW_RCNT + cls), 1, __ATOMIC_RELAXED, __HIP_MEMORY_SCOPE_WORKGROUP);
    }
    __syncthreads();
    if (tid < 24 && !dry) { const int n = misc[MW_RCNT + tid];
        misc[MW_RBASE + tid] = n > 0 ? (int)__hip_atomic_fetch_add((unsigned*)(F.ws + WS_CTL) + CW_CNT + (l * 32 + tid) * 64, (unsigned)n, __ATOMIC_RELAXED, __HIP_MEMORY_SCOPE_AGENT) : 0; }
    __syncthreads();
    if (lane < 16 && !dry) {
        const int pos = misc[MW_RBASE + cls] + rank;
        ((int*)(F.ws + WS_PERM))[(size_t)cls * T + pos] = tok;
        ((float*)(F.ws + WS_RW0))[tok] = w_lo; ((float*)(F.ws + WS_RW1))[tok] = w_hi; ((float*)(F.ws + WS_RSTD2))[tok] = rs;
    }
    __syncthreads();
}
__device__ __forceinline__ void moe_build_table(Ctx& F, int l) {
    LAS int* misc = (LAS int*)(F.lds + MISC_OFF);
    if (fresh_tid() == 0) {
        int s = 0;
        for (int c = 0; c < 24; ++c) { const int n = (int)__hip_atomic_load((unsigned*)(F.ws + WS_CTL) + CW_CNT + (l * 32 + c) * 64, __ATOMIC_RELAXED, __HIP_MEMORY_SCOPE_AGENT);
            misc[MW_TCNT + c] = n; misc[MW_TSTART + c] = s; s += (n + 255) >> 8; }
        misc[MW_TSTART + 24] = s;
    }
    __syncthreads();
}
__device__ __forceinline__ void moe_tile(const LAS int* misc, int tau, int& c, int& off, int& nvalid) {
    c = 0;
#pragma unroll 1
    for (int k = 1; k < 24; ++k) if (misc[MW_TSTART + k] <= tau) c = k;
#pragma unroll 1
    for (int k = 0; k < 24; ++k) if (misc[MW_TSTART + k] <= tau && tau < misc[MW_TSTART + k + 1]) c = k;
    off = (tau - misc[MW_TSTART + c]) * 256; nvalid = misc[MW_TCNT + c] - off; if (nvalid > 256) nvalid = 256;
}
__device__ __forceinline__ void cls_experts(int c, int& elo, int& ehi) {
    const int g = c / 6, p = c - g * 6;
    const int lo = p < 3 ? 0 : (p < 5 ? 1 : 2), hi = p < 3 ? p + 1 : (p < 5 ? p - 1 : 3);
    elo = 4 * g + lo; ehi = 4 * g + hi;
}
struct SchedMoeA {
    unsigned char* ws; const LAS int* misc; int G, c;
    __device__ __forceinline__ bool next(int i, GUnit& u) const {
        const int L = i * G + c, NT = misc[MW_TSTART + 24]; if (L >= NT * 4) return false;
        const int tau = L >> 2, pn = L & 3; int cl, off, nv; moe_tile(misc, tau, cl, off, nv);
        int elo, ehi; cls_experts(cl, elo, ehi); const int e = pn < 2 ? elo : ehi;
        u.A = (const char*)(ws + WS_XB); u.B = (const char*)(ws + WS_WGU) + ((size_t)e * 512 + (pn & 1) * 256) * 2048;
        u.lda2 = 2048; u.ldb2 = 2048; u.nt = 16; u.pm = tau; u.pn = pn; u.kind = 0; u.flags = 0;
        u.rows = (const int*)(ws + WS_PERM) + (size_t)cl * T + off; u.nvalid = nv; u.aux0 = cl; u.aux1 = 0; u.aux2 = 0;
        return true;
    }
};
struct EpiMoeA {
    unsigned char* ws;
    __device__ __forceinline__ void operator()(EPI_ARGS) const {
        EPI_LAUNDER;
        const int pn = u.pn, es = pn >> 1;
        const float* rw = (const float*)(ws + (es == 0 ? WS_RW0 : WS_RW1)); const float* rstd2 = (const float*)(ws + WS_RSTD2);
        bf16_t* hid = (bf16_t*)(ws + WS_HID);
        int tk[8]; float r2v[8], wv[8];
#pragma unroll
        for (int j = 0; j < 8; ++j) { const int ridx = (j >> 2) * 128 + wr * 64 + (j & 3) * 16 + fr; tk[j] = (ridx < u.nvalid) ? u.rows[ridx] : 0; }
#pragma unroll
        for (int j = 0; j < 8; ++j) { r2v[j] = rstd2[tk[j]]; wv[j] = rw[tk[j]]; }
#pragma unroll
        for (int ai = 0; ai < 2; ++ai)
#pragma unroll
            for (int m = 0; m < 4; ++m) {
                const int ridx = ai * 128 + wr * 64 + m * 16 + fr;
                if (ridx < u.nvalid) {
                    const float r2 = r2v[ai * 4 + m], w = wv[ai * 4 + m];
                    float gv[8], uv[8], h[8]; ACC8(gv, ai, 0, m, r2); ACC8(uv, ai, 1, m, r2);
#pragma unroll
                    for (int i = 0; i < 8; ++i) h[i] = gv[i] * sigmoid_f(gv[i]) * uv[i] * w;
                    *(u32x4*)(hid + ((size_t)u.pm * 256 + ridx) * 512 + es * 256 + (pn & 1) * 128 + wc * 32 + 8 * fq) = pack8(h);
                }
            }
    }
};
struct SchedMoeB {
    unsigned char* ws; const LAS int* misc; int G, c;
    __device__ __forceinline__ bool next(int i, GUnit& u) const {
        const int j = i & 1, L = (i >> 1) * G + c, NT = misc[MW_TSTART + 24]; if (L >= NT * 4) return false;
        const int tau = L >> 2, pn = L & 3; int cl, off, nv; moe_tile(misc, tau, cl, off, nv);
        int elo, ehi; cls_experts(cl, elo, ehi); const int e = j == 0 ? elo : ehi;
        u.A = (const char*)(ws + WS_HID) + (size_t)tau * 256 * 1024 + j * 512; u.B = (const char*)(ws + WS_WD) + ((size_t)e * 1024 + pn * 256) * 512;
        u.lda2 = 1024; u.ldb2 = 512; u.nt = 4; u.pm = tau; u.pn = pn; u.kind = 0; u.flags = (j == 0) ? 1 : 0;
        u.rows = (const int*)(ws + WS_PERM) + (size_t)cl * T + off; u.nvalid = nv; u.aux0 = cl; u.aux1 = 0; u.aux2 = 0;
        return true;
    }
};
struct EpiMoeB {
    unsigned char* ws; float* out; bool dry;
    __device__ __forceinline__ void operator()(EPI_ARGS) const {
        EPI_LAUNDER;
        bf16_t* xb = (bf16_t*)(ws + WS_XB); float* xpart = (float*)(ws + WS_XPART);
        int tk[8];
#pragma unroll
        for (int j = 0; j < 8; ++j) { const int ridx = (j >> 2) * 128 + wr * 64 + (j & 3) * 16 + fr; tk[j] = (ridx < u.nvalid) ? u.rows[ridx] : 0; }
#pragma unroll
        for (int ai = 0; ai < 2; ++ai) {
            f32x4 xa[8], xc[8];
#pragma unroll
            for (int j = 0; j < 8; ++j) { const size_t off = (size_t)tk[ai * 4 + (j >> 1)] * 1024 + u.pn * 256 + (j & 1) * 128 + wc * 32 + 8 * fq;
                xa[j] = *(const f32x4*)(out + off); xc[j] = *(const f32x4*)(out + off + 4); }
#pragma unroll
            for (int m = 0; m < 4; ++m) {
                const int ridx = ai * 128 + wr * 64 + m * 16 + fr; const bool st = (ridx < u.nvalid) && !dry;
                const int tok = tk[ai * 4 + m];
                float ss = 0.f;
#pragma unroll
                for (int bj = 0; bj < 2; ++bj) {
                    const size_t off = (size_t)tok * 1024 + u.pn * 256 + bj * 128 + wc * 32 + 8 * fq;
                    const f32x4 a = xa[m * 2 + bj] + acc[ai][bj][m][0], b = xc[m * 2 + bj] + acc[ai][bj][m][1];
                    ss += (a.x * a.x + a.y * a.y) + (a.z * a.z + a.w * a.w) + (b.x * b.x + b.y * b.y) + (b.z * b.z + b.w * b.w);
                    if (st) {
                        *(f32x4*)(out + off) = a; *(f32x4*)(out + off + 4) = b;
                        u32x4 w; w.x = pk2(a.x, a.y); w.y = pk2(a.z, a.w); w.z = pk2(b.x, b.y); w.w = pk2(b.z, b.w);
                        *(u32x4*)(xb + off) = w;
                    }
                }
                ss = fq_sum(ss);
                if (st && fq == 0) xpart[(size_t)tok * 16 + u.pn * 4 + wc] = ss;
            }
            asm volatile("" ::: "memory");
        }
    }
};

namespace att {
constexpr int GRP_LDS = 45056, OFF_K = 0, OFF_V = 24576, OFF_CK = 40960, OFF_TB = 41472;
#define ATT_WAITBAR() asm volatile("s_waitcnt vmcnt(0) lgkmcnt(0)\n\ts_barrier" ::: "memory")
#define ATT_BAR() asm volatile("s_waitcnt lgkmcnt(0)\n\ts_barrier" ::: "memory")
__device__ __forceinline__ s16x4 vtr(const LAS char* p) { return __builtin_bit_cast(s16x4, __builtin_amdgcn_ds_read_tr16_b64_v4i16((LAS s16x4*)p)); }

template <int TYPE>
__device__ __forceinline__ void attn_unit(unsigned char* ws, LAS unsigned char* lds, const float* rel_bias, int b, int hp, int br, int cls, int qb, int mergemode, bool dry = false) {
    constexpr int DK = (TYPE == 2) ? 96 : 64, NDS = DK / 16, NKC = DK / 8;
    const int tid = fresh_tid(), lane = tid & 63, r32 = lane & 31, hi = lane >> 5;
    const int wave = __builtin_amdgcn_readfirstlane(tid >> 6), grp = wave >> 2, w4 = wave & 3;
    const int h = 2 * hp + grp;
    LAS unsigned char* gl = lds + grp * GRP_LDS;
    const int dil = (TYPE == 0) ? (br == 0 ? 1 : (br == 1 ? 4 : 16)) : 1;
    const int rowb = b * SEQ + ((TYPE == 0) ? cls : 0);
    const int Q0 = qb * 128, qlo = Q0 + 32 * w4, qpos = qlo + r32;
    const int t0 = (TYPE == 0) ? ((qb >= 1) ? 2 * qb - 2 : 0) : 0;
    const int nsteps = (TYPE == 0) ? ((qb >= 1) ? 4 : 2) : 2 * qb + 2;
    const size_t qbytes = (TYPE == 0) ? WS_QA : (TYPE == 1 ? WS_QB : WS_QNOPE);
    const size_t kbytes = (TYPE == 0) ? WS_KA : (TYPE == 1 ? WS_KB : WS_KNOPE);
    const size_t vbytes = (TYPE == 0) ? WS_VA : (TYPE == 1 ? WS_VB : WS_VC);
    const size_t obytes = (TYPE == 0) ? WS_OA : (TYPE == 1 ? WS_QB : WS_QNOPE);
    const char* Kg = (const char*)(ws + kbytes) + h * 128; const char* Vg = (const char*)(ws + vbytes) + h * 128;
    const char* Krp = (const char*)(ws + WS_KROPE);
    const float* cum = (const float*)(ws + WS_CUM);
    const size_t qrow = (size_t)(rowb + qpos * dil);
    bf16x8 qf[NDS];
    {
        const char* qp = (const char*)(ws + qbytes) + qrow * 1024 + h * 128 + hi * 16;
#pragma unroll
        for (int ds = 0; ds < 4; ++ds) qf[ds] = *(const bf16x8*)(qp + ds * 32);
        if (TYPE == 2) { const char* qr = (const char*)(ws + WS_QROPE) + qrow * 512 + h * 64 + hi * 16;
#pragma unroll
            for (int ds = 4; ds < NDS; ++ds) qf[ds] = *(const bf16x8*)(qr + (ds - 4) * 32); }
    }
    float cq2 = 0.f; if (TYPE == 1) cq2 = cum[qrow * 8 + h];
    if (TYPE == 0) {
        LAS float* TB = (LAS float*)(gl + OFF_TB); const int idx = w4 * 64 + lane, dist = idx - 63;
        TB[idx] = (dist >= 0 && dist <= 128) ? rel_bias[(int)T5B[br][dist] * 8 + h] * LOG2E : -INFINITY;
    }
#define ATT_ISSUE(tau, bufi) do { \
        const int k0_ = (tau) * 64; \
        { const size_t krow_ = (size_t)(rowb + (k0_ + lane) * dil); \
          _Pragma("unroll") for (int c_ = w4; c_ < NKC; c_ += 4) { \
              const char* src_ = (c_ < 8) ? (Kg + krow_ * 1024 + c_ * 16) : (Krp + krow_ * 64 + (c_ - 8) * 16); \
              __builtin_amdgcn_global_load_lds((const unsigned*)src_, (LAS unsigned*)(gl + OFF_K + (bufi) * 12288 + c_ * 1024), 16, 0, 0); } } \
        { _Pragma("unroll") for (int p_ = w4; p_ < 8; p_ += 4) { \
              const size_t vrow_ = (size_t)(rowb + (k0_ + 16 * (p_ & 3) + (lane >> 2)) * dil); \
              const char* src_ = Vg + vrow_ * 1024 + (p_ >> 2) * 64 + (lane & 3) * 16; \
              __builtin_amdgcn_global_load_lds((const unsigned*)src_, (LAS unsigned*)(gl + OFF_V + (bufi) * 8192 + p_ * 1024), 16, 0, 0); } } \
        if (TYPE == 1 && w4 == 0) { const size_t krow_ = (size_t)(rowb + (k0_ + lane) * dil); \
              __builtin_amdgcn_global_load_lds((const unsigned*)(cum + krow_ * 8 + h), (LAS unsigned*)(gl + OFF_CK + (bufi) * 256), 4, 0, 0); } \
    } while (0)
    float mrun = -1e30f, lrun = 0.f;
    f32x16 o0 = {}, o1 = {};
    ATT_ISSUE(t0, 0);
#pragma unroll 1
    for (int s = 0; s < nsteps; ++s) {
        const int tau = t0 + s, bufi = s & 1;
        ATT_WAITBAR();
        if (s + 1 < nsteps) ATT_ISSUE(tau + 1, bufi ^ 1);
        const int k0 = tau * 64;
        bool part = (k0 <= qlo + 31);
        if (TYPE == 0) part = part && (k0 + 63 >= qlo - 128);
        if (part) {
            const LAS char* Kb = (const LAS char*)(gl + OFF_K + bufi * 12288);
            const LAS char* Vb = (const LAS char*)(gl + OFF_V + bufi * 8192);
            f32x16 s0 = {}, s1 = {};
#pragma unroll
            for (int ds = 0; ds < NDS; ++ds) {
                const bf16x8 a0 = *(const LAS bf16x8*)(Kb + (2 * ds + hi) * 1024 + r32 * 16);
                const bf16x8 a1 = *(const LAS bf16x8*)(Kb + (2 * ds + hi) * 1024 + 512 + r32 * 16);
                s0 = __builtin_amdgcn_mfma_f32_32x32x16_bf16(a0, qf[ds], s0, 0, 0, 0);
                s1 = __builtin_amdgcn_mfma_f32_32x32x16_bf16(a1, qf[ds], s1, 0, 0, 0);
            }
            if (TYPE == 0) {
                const LAS float* TB = (const LAS float*)(gl + OFF_TB) + (qpos - k0 - 4 * hi + 63);
#pragma unroll
                for (int i = 0; i < 16; ++i) { const int cr = (i & 3) + 8 * (i >> 2); s0[i] += TB[-cr]; s1[i] += TB[-cr - 32]; }
            }
            if (TYPE == 1) {
                const LAS float* CK = (const LAS float*)(gl + OFF_CK + bufi * 256) + 4 * hi;
#pragma unroll
                for (int g4 = 0; g4 < 4; ++g4) {
                    const f32x4 c0 = *(const LAS f32x4*)(CK + 8 * g4), c1 = *(const LAS f32x4*)(CK + 32 + 8 * g4);
                    s0[4 * g4 + 0] += cq2 - c0.x; s0[4 * g4 + 1] += cq2 - c0.y; s0[4 * g4 + 2] += cq2 - c0.z; s0[4 * g4 + 3] += cq2 - c0.w;
                    s1[4 * g4 + 0] += cq2 - c1.x; s1[4 * g4 + 1] += cq2 - c1.y; s1[4 * g4 + 2] += cq2 - c1.z; s1[4 * g4 + 3] += cq2 - c1.w;
                }
            }
            if (TYPE != 0) {
                if (k0 + 63 > qlo) {
                    const int kb = k0 + 4 * hi;
#pragma unroll
                    for (int i = 0; i < 16; ++i) { const int kv = kb + (i & 3) + 8 * (i >> 2); if (kv > qpos) s0[i] = -INFINITY; if (kv + 32 > qpos) s1[i] = -INFINITY; }
                }
            }
            float mx = s0[0];
#pragma unroll
            for (int i = 1; i < 16; ++i) mx = fmaxf(mx, s0[i]);
#pragma unroll
            for (int i = 0; i < 16; ++i) mx = fmaxf(mx, s1[i]);
            mx = fmaxf(mx, __shfl_xor(mx, 32));
            const float mn = fmaxf(mrun, mx);
            const float alpha = fast_exp2(mrun - mn);
            mrun = mn;
            float rsum = 0.f;
#pragma unroll
            for (int i = 0; i < 16; ++i) { s0[i] = fast_exp2(s0[i] - mn); rsum += s0[i]; }
#pragma unroll
            for (int i = 0; i < 16; ++i) { s1[i] = fast_exp2(s1[i] - mn); rsum += s1[i]; }
            lrun = lrun * alpha + rsum;
#pragma unroll
            for (int i = 0; i < 16; ++i) { o0[i] *= alpha; o1[i] *= alpha; }
            u32x4 pw[4];
            pw[0] = (u32x4){pk2(s0[0], s0[1]), pk2(s0[2], s0[3]), pk2(s0[4], s0[5]), pk2(s0[6], s0[7])};
            pw[1] = (u32x4){pk2(s0[8], s0[9]), pk2(s0[10], s0[11]), pk2(s0[12], s0[13]), pk2(s0[14], s0[15])};
            pw[2] = (u32x4){pk2(s1[0], s1[1]), pk2(s1[2], s1[3]), pk2(s1[4], s1[5]), pk2(s1[6], s1[7])};
            pw[3] = (u32x4){pk2(s1[8], s1[9]), pk2(s1[10], s1[11]), pk2(s1[12], s1[13]), pk2(s1[14], s1[15])};
            const LAS char* vp = Vb + (4 * hi + ((lane & 15) >> 2)) * 64 + ((lane >> 4) & 1) * 32 + (lane & 3) * 8;
#pragma unroll
            for (int ks = 0; ks < 4; ++ks) {
                const s16x4 a_lo = vtr(vp + ks * 1024), a_hi = vtr(vp + ks * 1024 + 512);
                const s16x4 b_lo = vtr(vp + 4096 + ks * 1024), b_hi = vtr(vp + 4096 + ks * 1024 + 512);
                const bf16x8 va = (bf16x8){a_lo[0], a_lo[1], a_lo[2], a_lo[3], a_hi[0], a_hi[1], a_hi[2], a_hi[3]};
                const bf16x8 vb = (bf16x8){b_lo[0], b_lo[1], b_lo[2], b_lo[3], b_hi[0], b_hi[1], b_hi[2], b_hi[3]};
                const bf16x8 pf = __builtin_bit_cast(bf16x8, pw[ks]);
                o0 = __builtin_amdgcn_mfma_f32_32x32x16_bf16(va, pf, o0, 0, 0, 0);
                o1 = __builtin_amdgcn_mfma_f32_32x32x16_bf16(vb, pf, o1, 0, 0, 0);
            }
        }
    }
    const float ltot = lrun + __shfl_xor(lrun, 32);
    float ca = 0.f, cb = 1.f / ltot;
    float* lsep = (float*)(ws + WS_LSE) + qrow * 8 + h;
    char* op = (char*)(ws + obytes) + qrow * 1024 + h * 128 + hi * 8;
    if (TYPE == 0) {
        const float lc = mrun + fast_log2(ltot);
        if (mergemode == 0) { if (hi == 0 && !dry) *lsep = lc; }
        else {
            const float lp = *lsep;
            const float M = fmaxf(lp, lc), wp = fast_exp2(lp - M), wn = fast_exp2(lc - M), den = wp + wn;
            ca = wp / den; cb = wn / (den * ltot);
            if (mergemode == 1 && hi == 0 && !dry) *lsep = M + fast_log2(den);
        }
    }
#pragma unroll
    for (int gi = 0; gi < 4; ++gi) {
        float v0[4], v1[4];
#pragma unroll
        for (int e = 0; e < 4; ++e) { v0[e] = o0[4 * gi + e] * cb; v1[e] = o1[4 * gi + e] * cb; }
        if (TYPE == 0 && mergemode != 0) {
            const u32x2 p0 = *(const u32x2*)(op + gi * 16), p1 = *(const u32x2*)(op + 64 + gi * 16);
            v0[0] += ca * bflo(p0.x); v0[1] += ca * bfhi(p0.x); v0[2] += ca * bflo(p0.y); v0[3] += ca * bfhi(p0.y);
            v1[0] += ca * bflo(p1.x); v1[1] += ca * bfhi(p1.x); v1[2] += ca * bflo(p1.y); v1[3] += ca * bfhi(p1.y);
        }
        u32x2 w0, w1; w0.x = pk2(v0[0], v0[1]); w0.y = pk2(v0[2], v0[3]); w1.x = pk2(v1[0], v1[1]); w1.y = pk2(v1[2], v1[3]);
        if (!dry) { *(u32x2*)(op + gi * 16) = w0; *(u32x2*)(op + 64 + gi * 16) = w1; }
    }
    ATT_BAR();
#undef ATT_ISSUE
}
}

#ifndef PHMASK
#define PHMASK 0xffffffffu
#endif
#define PH(n) ((PHMASK >> (n)) & 1u)
#ifndef DUPMASK
#define DUPMASK 0u
#endif
#define DUP(n) ((DUPMASK >> (n)) & 1u)
#define FRESH_WS() do { asm volatile("" : "+s"(ws)); F.ws = ws; } while (0)
__device__ __forceinline__ void phase_scan(Ctx& F) {
    const int tid = fresh_tid(), lane = tid & 63, b = F.vcu, h = __builtin_amdgcn_readfirstlane(tid >> 6);
    const float* lf = (const float*)(F.ws + WS_LOGF) + (size_t)(b * SEQ + 32 * lane) * 8 + h;
    float* cm = (float*)(F.ws + WS_CUM) + (size_t)(b * SEQ + 32 * lane) * 8 + h;
    float v[32];
#pragma unroll
    for (int i = 0; i < 32; ++i) v[i] = lf[i * 8];
#pragma unroll
    for (int i = 1; i < 32; ++i) v[i] += v[i - 1];
    const float total = v[31]; float incl = total;
#pragma unroll
    for (int o = 1; o < 64; o <<= 1) { const float n = __shfl_up(incl, o); if (lane >= o) incl += n; }
    const float excl = incl - total;
#pragma unroll
    for (int i = 0; i < 32; ++i) cm[i * 8] = (excl + v[i]) * LOG2E;
}

__global__ void __launch_bounds__(512, 2) mega_fwd(Args args) {
    extern __shared__ __attribute__((aligned(16))) unsigned char lds_raw[];
    Ctx F;
    F.lds = (LAS unsigned char*)lds_raw; F.ws = args.ws; F.out = args.out;
    F.tid = threadIdx.x; F.lane = F.tid & 63; F.wave = __builtin_amdgcn_readfirstlane(F.tid >> 6);
    F.G = gridDim.x; { const int bx = blockIdx.x; F.vcu = (F.G % 8 == 0) ? (bx % 8) * (F.G / 8) + bx / 8 : bx; }
    unsigned char* ws = F.ws;
    LAS int* misc = (LAS int*)(F.lds + MISC_OFF);
    for (int i = F.tid; i < 1024; i += 512) misc[i] = 0;
    if (F.tid < 26) *(LAS unsigned long long*)(F.lds + ARGTAB_OFF + 8 * F.tid) = (unsigned long long)args.in[F.tid];
    __syncthreads();
    XcdBarrier bar = xcd_barrier_post((unsigned*)(ws + WS_CTL) + CW_BAR, (volatile LAS unsigned*)(misc + MW_BAR));
    const int bx = blockIdx.x, G = F.G, bhp = F.vcu >> 2, sub = F.vcu & 3, ab = bhp >> 2, ahp = bhp & 3;

#pragma unroll 1
    for (int l = 0; l < NLAYER; ++l) {
        FRESH_WS();
        for (int rep = 0; rep <= (int)DUP(0); ++rep) phase_p0(F, l);
        for (int rep = 0; rep <= (int)DUP(14); ++rep) xcd_barrier(bar);
        FRESH_WS();
        for (int rep = 0; rep <= (int)DUP(1); ++rep) { SchedP1 S{ws, G, bx}; EpiP1 E{ws, argf(F, IN_GK_C) + l * 96 + 64, argf(F, IN_B_FORGET) + l * 8};
          g8::gemm_run<EpiP1, SchedP1, false>(F.lds, S, E); }
        for (int rep = 0; rep <= (int)DUP(14); ++rep) xcd_barrier(bar);
        FRESH_WS();
        for (int rep = 0; rep <= (int)DUP(2); ++rep) { SchedP2 S{ws, G, bx}; EpiP2 E{ws, argf(F, IN_GQ_C) + l * 96, argf(F, IN_GK_C) + l * 96};
          g8::gemm_run<EpiP2, SchedP2, false>(F.lds, S, E); }
        if (F.vcu < NBATCH) phase_scan(F);
#pragma unroll 1
        for (int rep = 0; rep <= (int)DUP(4); ++rep)
#pragma unroll 1
        for (int k = 0; k < 4; ++k) att::attn_unit<0>(ws, F.lds, argf(F, IN_RELB), ab, ahp, 2, 4 * sub + k, 0, 0, rep != 0);
        for (int rep = 0; rep <= (int)DUP(14); ++rep) xcd_barrier(bar);
        FRESH_WS();
#pragma unroll 1
        for (int rep = 0; rep <= (int)DUP(4); ++rep)
#pragma unroll 1
        for (int k = 0; k < 4; ++k) att::attn_unit<0>(ws, F.lds, argf(F, IN_RELB), ab, ahp, 1, sub, k, 1, rep == 0 && DUP(4));
#pragma unroll 1
        for (int rep = 0; rep <= (int)DUP(6); ++rep)
#pragma unroll 1
        for (int k = 0; k < 4; ++k) { const int qb = (k == 0) ? sub : (k == 1 ? 7 - sub : (k == 2 ? 8 + sub : 15 - sub)); att::attn_unit<1>(ws, F.lds, argf(F, IN_RELB), ab, ahp, 0, 0, qb, 0, rep == 0 && DUP(6)); }
        for (int rep = 0; rep <= (int)DUP(14); ++rep) xcd_barrier(bar);
        FRESH_WS();
#pragma unroll 1
        for (int rep = 0; rep <= (int)DUP(4); ++rep)
#pragma unroll 1
        for (int k = 0; k < 4; ++k) att::attn_unit<0>(ws, F.lds, argf(F, IN_RELB), ab, ahp, 0, 0, 4 * sub + k, 2, rep == 0 && DUP(4));
#pragma unroll 1
        for (int rep = 0; rep <= (int)DUP(8); ++rep)
#pragma unroll 1
        for (int k = 0; k < 4; ++k) { const int qb = (k == 0) ? sub : (k == 1 ? 7 - sub : (k == 2 ? 8 + sub : 15 - sub)); att::attn_unit<2>(ws, F.lds, argf(F, IN_RELB), ab, ahp, 0, 0, qb, 0, rep == 0 && DUP(8)); }
        for (int rep = 0; rep <= (int)DUP(14); ++rep) xcd_barrier(bar);
        FRESH_WS();
        for (int rep = 0; rep <= (int)DUP(9); ++rep) { SchedP4 S{ws, G, bx}; EpiP4 E{ws, F.vcu};
          g8::gemm_run<EpiP4, SchedP4, false>(F.lds, S, E); }
        for (int rep = 0; rep <= (int)DUP(14); ++rep) xcd_barrier(bar);
        FRESH_WS();
        for (int rep = 0; rep <= (int)DUP(10); ++rep) { SchedP5 S{ws, G, bx}; EpiP5 E{ws, F.out, rep == 0 && DUP(10)};
          g8::gemm_run<EpiP5, SchedP5, false>(F.lds, S, E); }
        for (int rep = 0; rep <= (int)DUP(14); ++rep) xcd_barrier(bar);
        FRESH_WS();
        for (int rep = 0; rep <= (int)DUP(11); ++rep) phase_router(F, l, rep == 0 && DUP(11));
        for (int rep = 0; rep <= (int)DUP(14); ++rep) xcd_barrier(bar);
        FRESH_WS();
        moe_build_table(F, l);
        for (int rep = 0; rep <= (int)DUP(12); ++rep) { SchedMoeA S{ws, (const LAS int*)misc, G, bx}; EpiMoeA E{ws};
          g8::gemm_run<EpiMoeA, SchedMoeA, true>(F.lds, S, E); }
        for (int rep = 0; rep <= (int)DUP(14); ++rep) xcd_barrier(bar);
        FRESH_WS();
        for (int rep = 0; rep <= (int)DUP(13); ++rep) { SchedMoeB S{ws, (const LAS int*)misc, G, bx}; EpiMoeB E{ws, F.out, rep == 0 && DUP(13)};
          g8::gemm_run<EpiMoeB, SchedMoeB, false>(F.lds, S, E); }
        for (int rep = 0; rep <= (int)DUP(14); ++rep) xcd_barrier(bar);
    }
}

extern "C" void kernel_launch(void* const* d_in, const int* in_sizes, int n_in, void* d_out, int out_size, void* d_ws, size_t ws_size, hipStream_t stream) {
    static int ready = 0;
    if (ready == 0) {
        ready = 1;
        if (n_in != 26 || out_size != T * DM || ws_size < WS_END) { fprintf(stderr, "kernel_launch: unexpected problem (n_in %d, out %d, ws %zu)\n", n_in, out_size, ws_size); ready = -1; }
        else if (hipFuncSetAttribute((const void*)mega_fwd, hipFuncAttributeMaxDynamicSharedMemorySize, LDS_BYTES) != hipSuccess) { fprintf(stderr, "kernel_launch: hipFuncSetAttribute failed\n"); ready = -1; }
        (void)hipGetLastError();
    }
    if (ready < 0) return;
    (void)hipMemsetAsync((char*)d_ws + WS_CTL, 0, CTL_ZERO_BYTES, stream);
    Args a{};
    for (int i = 0; i < 26; ++i) a.in[i] = d_in[i];
    a.out = (float*)d_out; a.ws = (unsigned char*)d_ws;
    hipLaunchKernelGGL(mega_fwd, dim3(256), dim3(512), LDS_BYTES, stream, a);
}
```
